# Optimizing an MI355X kernel written in HIP

```python
import jax, jax.numpy as jnp
from jax import lax
import numpy as np

D_MODEL = 2048
BATCH = 4
SEQ = 4096
DEPTH = 1

EPS = 1e-6
SSM_D_INNER = 2048
SSM_HEAD_DIM = 64
SSM_HEADS = SSM_D_INNER // SSM_HEAD_DIM
SSM_GROUPS = 8
SSM_STATE = 128
SSM_CONV_K = 5
SSM_CHUNK = 128
SSM_XBC = SSM_D_INNER + 2 * SSM_GROUPS * SSM_STATE
ATTN_HEAD_DIM = 128
ATTN_Q_HEADS = 16
ATTN_KV_HEADS = 4
ATTN_Q_BLOCK = 128
ROPE_THETA = 10000.0
GRID_W = 64
D_FF = 4 * D_MODEL
IN_SIZES = (SSM_D_INNER, SSM_XBC, SSM_HEADS, SSM_HEADS,
            ATTN_Q_HEADS * ATTN_HEAD_DIM, ATTN_KV_HEADS * ATTN_HEAD_DIM, ATTN_KV_HEADS * ATTN_HEAD_DIM,
            D_MODEL, D_MODEL)
N_IN = sum(IN_SIZES)

kernel_name = "hybrid_ssd_axial_gqa_gated_encoder"


def rms_norm(x, g):
    xf = x.astype(jnp.float32)
    y = xf * lax.rsqrt(jnp.mean(xf * xf, axis=-1, keepdims=True) + EPS)
    return (y * g.astype(jnp.float32)).astype(x.dtype)


def split_points(sizes):
    pts, acc = [], 0
    for s in sizes[:-1]:
        acc += s
        pts.append(acc)
    return pts


def centred_depthwise_conv(u, w, b):
    c = u.shape[-1]
    k = w.shape[0]
    out = lax.conv_general_dilated(
        u, w.reshape(k, 1, c).astype(u.dtype), window_strides=(1,),
        padding=[(k // 2, k // 2)], dimension_numbers=("NWC", "WIO", "NWC"),
        feature_group_count=c)
    return out + b.astype(u.dtype)


def ssd_scan(xh, a, bg, cg, chunk):
    b, s, h, p = xh.shape
    g, n = bg.shape[-2:]
    r = h // g
    c = s // chunk
    x = xh.reshape(b, c, chunk, g, r, p)
    a = a.reshape(b, c, chunk, g, r)
    bm = bg.reshape(b, c, chunk, g, n)
    cm = cg.reshape(b, c, chunk, g, n)
    a_cum = jnp.cumsum(a, axis=2)
    seg = a_cum[:, :, :, None] - a_cum[:, :, None, :]
    mask = jnp.tril(jnp.ones((chunk, chunk), dtype=bool))[:, :, None, None]
    decay = jnp.exp(jnp.where(mask, seg, -jnp.inf))
    scores = jnp.einsum('bclgn,bcsgn->bclsg', cm, bm)
    y_diag = jnp.einsum('bclsg,bclsgr,bcsgrp->bclgrp', scores, decay, x)
    decay_to_end = jnp.exp(a_cum[:, :, -1:] - a_cum)
    chunk_states = jnp.einsum('bclgn,bclgr,bclgrp->bcgrpn', bm, decay_to_end, x)
    chunk_decay = jnp.exp(a_cum[:, :, -1])

    def step(state, inp):
        st, dec = inp
        return state * dec[..., None, None] + st, state

    init = jnp.zeros((b, g, r, p, n), chunk_states.dtype)
    _, states_in = lax.scan(step, init, (jnp.moveaxis(chunk_states, 1, 0), jnp.moveaxis(chunk_decay, 1, 0)))
    states_in = jnp.moveaxis(states_in, 0, 1)
    y_off = jnp.einsum('bclgn,bcgrpn,bclgr->bclgrp', cm, states_in, jnp.exp(a_cum))
    return (y_diag + y_off).reshape(b, s, h, p)


def mamba2_bidir(z, xbc, dt_f, dt_b, conv_w, conv_b, dt_bias_f, dt_bias_b, a_log_f, a_log_b, d_skip, norm_g):
    b, s, _ = z.shape
    xbc = jax.nn.silu(centred_depthwise_conv(xbc, conv_w, conv_b))
    xs, bm, cm = jnp.split(xbc, [SSM_D_INNER, SSM_D_INNER + SSM_GROUPS * SSM_STATE], axis=-1)
    xs = xs.reshape(b, s, SSM_HEADS, SSM_HEAD_DIM)
    bm = bm.reshape(b, s, SSM_GROUPS, SSM_STATE)
    cm = cm.reshape(b, s, SSM_GROUPS, SSM_STATE)

    def direction(xs_d, bm_d, cm_d, dt_raw, dt_bias, a_log):
        dt = jax.nn.softplus(dt_raw.astype(jnp.float32) + dt_bias.astype(jnp.float32))
        a = -jnp.exp(a_log.astype(jnp.float32)) * dt
        return ssd_scan(xs_d * dt[..., None], a, bm_d, cm_d, SSM_CHUNK)

    flip = lambda t: jnp.flip(t, axis=1)
    y_f = direction(xs, bm, cm, dt_f, dt_bias_f, a_log_f)
    y_b = flip(direction(flip(xs), flip(bm), flip(cm), flip(dt_b), dt_bias_b, a_log_b))
    y = y_f + y_b + d_skip.astype(jnp.float32)[:, None] * xs
    y = y.reshape(b, s, SSM_D_INNER) * jax.nn.silu(z.astype(jnp.float32))
    y = rms_norm(y.reshape(b, s, SSM_GROUPS, SSM_D_INNER // SSM_GROUPS),
                 norm_g.reshape(SSM_GROUPS, SSM_D_INNER // SSM_GROUPS))
    return y.reshape(b, s, SSM_D_INNER).astype(z.dtype)


def axial_rope_tables(seq):
    rows = seq // GRID_W
    row = jnp.repeat(jnp.arange(rows, dtype=jnp.float32), GRID_W)
    col = jnp.tile(jnp.arange(GRID_W, dtype=jnp.float32), rows)
    half = ATTN_HEAD_DIM // 2
    inv_freq = 1.0 / (ROPE_THETA ** (jnp.arange(0, half, 2, dtype=jnp.float32) / half))
    ang = jnp.concatenate([row[:, None] * inv_freq, col[:, None] * inv_freq], axis=-1)
    return jnp.cos(ang), jnp.sin(ang)


def apply_rope(x, cos, sin):
    b, s, h, d = x.shape
    xf = x.astype(jnp.float32).reshape(b, s, h, d // 2, 2)
    x0, x1 = xf[..., 0], xf[..., 1]
    c = cos[None, :, None, :]
    sn = sin[None, :, None, :]
    out = jnp.stack([x0 * c - x1 * sn, x0 * sn + x1 * c], axis=-1)
    return out.reshape(b, s, h, d).astype(x.dtype)


def gqa_bidir_blocks(q, k, v):
    b, s, hq, d = q.shape
    hkv = k.shape[2]
    r = hq // hkv
    nblk = s // ATTN_Q_BLOCK
    scale = d ** -0.5
    qb = (q * scale).reshape(b, nblk, ATTN_Q_BLOCK, hkv, r, d).transpose(1, 0, 2, 3, 4, 5)

    def one_block(qblk):
        sc = jnp.einsum('blkrd,bskd->bkrls', qblk, k).astype(jnp.float32)
        prob = jax.nn.softmax(sc, axis=-1).astype(v.dtype)
        return jnp.einsum('bkrls,bskd->blkrd', prob, v)

    out = lax.map(one_block, qb)
    return out.transpose(1, 0, 2, 3, 4, 5).reshape(b, s, hq * d)


def setup_inputs(seed: int = 0) -> dict:
    key = jax.random.key(seed)
    ks = jax.random.split(key, 24)
    f32 = jnp.float32
    nrm = lambda k, shape, scale: jax.random.normal(k, shape, f32) * scale
    gain = lambda k, shape: 1.0 + 0.02 * jax.random.normal(k, shape, f32)
    L = DEPTH
    dt_lo, dt_hi = 1e-3, 1e-1

    def dt_bias(k):
        u = jax.random.uniform(k, (L, SSM_HEADS), f32)
        dt = jnp.exp(u * (np.log(dt_hi) - np.log(dt_lo)) + np.log(dt_lo))
        return dt + jnp.log(-jnp.expm1(-dt))

    def a_log(k):
        return jnp.log(jax.random.uniform(k, (L, SSM_HEADS), f32, 1.0, 16.0))

    return {
        "x": jax.random.normal(ks[0], (BATCH, SEQ, D_MODEL), f32),
        "g_mix": gain(ks[1], (L, D_MODEL)),
        "w_in": nrm(ks[2], (L, D_MODEL, N_IN), D_MODEL ** -0.5),
        "conv_w": nrm(ks[3], (L, SSM_CONV_K, SSM_XBC), SSM_CONV_K ** -0.5),
        "conv_b": nrm(ks[4], (L, SSM_XBC), 0.02),
        "dt_bias_f": dt_bias(ks[5]),
        "dt_bias_b": dt_bias(ks[6]),
        "a_log_f": a_log(ks[7]),
        "a_log_b": a_log(ks[8]),
        "d_skip": gain(ks[9], (L, SSM_HEADS)),
        "ssm_norm_g": gain(ks[10], (L, SSM_D_INNER)),
        "q_norm_g": gain(ks[11], (L, ATTN_HEAD_DIM)),
        "k_norm_g": gain(ks[12], (L, ATTN_HEAD_DIM)),
        "w_ssm_up": nrm(ks[13], (L, SSM_D_INNER, D_MODEL), SSM_D_INNER ** -0.5),
        "w_attn_up": nrm(ks[14], (L, ATTN_Q_HEADS * ATTN_HEAD_DIM, D_MODEL), (ATTN_Q_HEADS * ATTN_HEAD_DIM) ** -0.5),
        "w_out": nrm(ks[15], (L, D_MODEL, D_MODEL), D_MODEL ** -0.5),
        "g_mlp": gain(ks[16], (L, D_MODEL)),
        "w_mlp_in": nrm(ks[17], (L, D_MODEL, D_FF), D_MODEL ** -0.5),
        "w_mlp_out": nrm(ks[18], (L, D_FF, D_MODEL), D_FF ** -0.5),
        "g_final": gain(ks[19], (D_MODEL,)),
    }


def reference(x, g_mix, w_in, conv_w, conv_b, dt_bias_f, dt_bias_b, a_log_f, a_log_b, d_skip,
              ssm_norm_g, q_norm_g, k_norm_g, w_ssm_up, w_attn_up, w_out, g_mlp, w_mlp_in,
              w_mlp_out, g_final):
    b, s, _ = x.shape
    cos, sin = axial_rope_tables(s)
    for layer in range(DEPTH):
        h = rms_norm(x, g_mix[layer])
        proj = h @ w_in[layer]
        z, xbc, dt_f, dt_b, q, k, v, gate_a, gate_b = jnp.split(proj, split_points(IN_SIZES), axis=-1)

        y_ssm = mamba2_bidir(z, xbc, dt_f, dt_b, conv_w[layer], conv_b[layer],
                             dt_bias_f[layer], dt_bias_b[layer], a_log_f[layer], a_log_b[layer],
                             d_skip[layer], ssm_norm_g[layer])

        q = rms_norm(q.reshape(b, s, ATTN_Q_HEADS, ATTN_HEAD_DIM), q_norm_g[layer])
        k = rms_norm(k.reshape(b, s, ATTN_KV_HEADS, ATTN_HEAD_DIM), k_norm_g[layer])
        v = v.reshape(b, s, ATTN_KV_HEADS, ATTN_HEAD_DIM)
        q = apply_rope(q, cos, sin)
        k = apply_rope(k, cos, sin)
        y_attn = gqa_bidir_blocks(q, k, v)

        branch_a = y_ssm @ w_ssm_up[layer]
        branch_b = y_attn @ w_attn_up[layer]
        merged = jax.nn.sigmoid(gate_a) * branch_a + jax.nn.sigmoid(gate_b) * branch_b
        x = x + merged @ w_out[layer]
        h2 = rms_norm(x, g_mlp[layer])
        x = x + jnp.square(jax.nn.relu(h2 @ w_mlp_in[layer])) @ w_mlp_out[layer]
    return rms_norm(x, g_final)
```

```cpp
#include <hip/hip_runtime.h>
#include <hip/hip_bf16.h>
#include <hip/hip_cooperative_groups.h>
#include <cstdio>
#include <cstdint>
namespace cg = cooperative_groups;

typedef unsigned short u16;
typedef short s16x4v __attribute__((ext_vector_type(4)));
typedef float f32x2v __attribute__((ext_vector_type(2)));
typedef unsigned u32x2v __attribute__((ext_vector_type(2)));
#define LAS3 __attribute__((address_space(3)))

constexpr int T_TOK = 16384, SEQ = 4096, DM = 2048, DFF = 8192, NIN = 13376;
constexpr int NPROJ_PAD = 13312;
constexpr float EPSN = 1e-6f;
constexpr size_t MiB = 1024 * 1024;
constexpr size_t WS_R0 = 0;
constexpr size_t WS_Z = 128 * MiB;
constexpr size_t WS_Q = 192 * MiB;
constexpr size_t WS_K = 256 * MiB;
constexpr size_t WS_V = 272 * MiB;
constexpr size_t WS_GA = 288 * MiB;
constexpr size_t WS_GB = 320 * MiB;
constexpr size_t WS_MG = 352 * MiB;
constexpr size_t WS_U = 128 * MiB;
constexpr size_t WS_WSSM = 416 * MiB;
constexpr size_t WS_WATT = 424 * MiB;
constexpr size_t WS_WOUT = 432 * MiB;
constexpr size_t WS_W2T = 440 * MiB;
constexpr size_t WS_DT = 472 * MiB;
constexpr size_t WS_ROPE = 476 * MiB;
constexpr size_t WS_CDEC = WS_ROPE + 64 * 1024;
constexpr size_t WS_BAR = WS_ROPE + 128 * 1024;
constexpr size_t WS_PCNT = WS_ROPE + 144 * 1024;
constexpr size_t BAR_ZERO_BYTES = 48 * 1024;
constexpr size_t WS_SSQ1 = 477 * MiB;
constexpr size_t WS_SSQ2 = WS_SSQ1;
constexpr size_t WS_W1T = 479 * MiB;
constexpr size_t WS_END = 511 * MiB;
constexpr size_t WS_DUMP = WS_ROPE + 256 * 1024;
constexpr size_t DO_H = 0, DO_WIN = 64 * MiB, DO_XBC = 0, DO_X1B = 0, DO_W1T = 64 * MiB;

constexpr int LDS_BYTES = 148 * 1024;

struct Params {
    const float* x; const float* g_mix; const float* w_in; const float* conv_w; const float* conv_b;
    const float* dt_bias_f; const float* dt_bias_b; const float* a_log_f; const float* a_log_b; const float* d_skip;
    const float* ssm_norm_g; const float* q_norm_g; const float* k_norm_g; const float* w_ssm_up; const float* w_attn_up;
    const float* w_out; const float* g_mlp; const float* w_mlp_in; const float* w_mlp_out; const float* g_final;
    float* out; unsigned char* ws; __hip_bfloat16* aq; const __hip_bfloat16* ak; const __hip_bfloat16* av; int seq; int pad;
};

__device__ __forceinline__ float bf2f(u16 v) { return __uint_as_float(((unsigned)v) << 16); }
__device__ __forceinline__ unsigned cvtpk2(float lo, float hi) { unsigned r; asm volatile("v_cvt_pk_bf16_f32 %0, %1, %2" : "=v"(r) : "v"(lo), "v"(hi)); return r; }
__device__ __forceinline__ u16 f2bf(float x) { return (u16)(cvtpk2(x, 0.f) & 0xffffu); }
__device__ __forceinline__ float lo_bf(unsigned w) { return __uint_as_float(w << 16); }
__device__ __forceinline__ float hi_bf(unsigned w) { return __uint_as_float(w & 0xffff0000u); }
__device__ __forceinline__ float sigmoidf_(float x) { return __builtin_amdgcn_rcpf(1.f + __expf(-x)); }
__device__ __forceinline__ float siluf_(float x) { return x * __builtin_amdgcn_rcpf(1.f + __expf(-x)); }

__device__ __forceinline__ int opaque_tid() { int t = threadIdx.x; asm volatile("" : "+v"(t)); return t; }

namespace pg8 {
#define PG8_LAS __attribute__((address_space(3)))
typedef unsigned short bf16_t;
typedef short bf16x8 __attribute__((ext_vector_type(8)));
typedef float f32x4 __attribute__((ext_vector_type(4)));
typedef unsigned u32x4 __attribute__((ext_vector_type(4)));
constexpr int BM = 256, BK = 64, HALF = 128, HTB = HALF * BK * 2  , STAGE_BYTES = 8 * HTB, NXCD = 8, WGM = 8;

__host__ __device__ __forceinline__ int lds_byte(int r, int c) { const int st = (r >> 4) * 2 + (c >> 5), rr = r & 15, cc = c & 31, ob = rr * 64 + cc * 2; return st * 1024 + (ob ^ (((ob >> 9) & 1) << 5)); }
__host__ __device__ __forceinline__ void stage_rc(int b, int& R, int& C) { const int st = b / 1024, sb = b % 1024, swz = sb ^ (((sb >> 9) & 1) << 5); R = (st >> 1) * 16 + swz / 64; C = (st & 1) * 32 + (swz % 64) / 2; }
__host__ __device__ __forceinline__ int perm32(int rho) { const int n = rho >> 4, i = rho & 15; return 8 * (i >> 2) + 4 * n + (i & 3); }

struct Unit { int pm, pn; };
struct Gemm { const bf16_t* A; const bf16_t* Bt; int M, N, K; const bf16_t* A2; const bf16_t* Bt2; };

struct StaticOrder {
    int nM, nN, nwg, G, c;
    __host__ __device__ void init(int M, int N, int G_, int c_) { nM = M / BM; nN = N / BM; nwg = nM * nN; G = G_; c = c_; }
    __host__ __device__ bool next(int i, Unit& u) const {
        const long L = (long)i * G + c; if (L >= nwg) return false;
        int wgid = (int)L; { const int q = nwg / NXCD, r = nwg % NXCD, xcd = wgid % NXCD, off = wgid / NXCD; wgid = (xcd < r ? xcd * (q + 1) : r * (q + 1) + (xcd - r) * q) + off; }
        const int nig = WGM * nN, gid = wgid / nig, fm = gid * WGM, gsz = (nM - fm) < WGM ? (nM - fm) : WGM;
        u.pm = fm + ((wgid % nig) % gsz); u.pn = (wgid % nig) / gsz; return true;
    }
    __device__ __forceinline__ void a_ready(const Unit&) const {}
    __device__ __forceinline__ void done(const Unit&) const {}
};
template <class Epi, class Sched, bool ALIGN_EPI = false, bool SP2 = false, bool DUAL = false>
__device__ __forceinline__ void gemm_phase(PG8_LAS unsigned char* lds, const Gemm g, const Sched& S, const Epi& E) {
    const int tid = opaque_tid(), wid = __builtin_amdgcn_readfirstlane(tid >> 6), lane = tid & 63, wr = wid >> 2, wc = wid & 3, fr = lane & 15, fq = lane >> 4;
    const int K = g.K, nh = K / BK, nt = DUAL ? 2 * nh : nh;
    unsigned voffA[2], voffB[2];
#pragma unroll
    for (int i = 0; i < 2; ++i) { int R, C; stage_rc(tid * 16 + i * 8192, R, C); const int Rb = Epi::PERM ? ((R & ~31) + perm32(R & 31)) : R;
        voffA[i] = (unsigned)(R * K + C) * 2u; voffB[i] = (unsigned)(Rb * K + C) * 2u; }
    const size_t kstep = (size_t)(BK * 2);
    const size_t hstep = (size_t)HALF * K * 2;
    const size_t tstep = 2 * hstep;
    const unsigned ldsw = (unsigned)wid * 1024u;
    const int aoff = lds_byte(wr * 64 + fr, fq * 8), boff = lds_byte(wc * 32 + fr, fq * 8);
#define PG8_SA(b, h) (((b) * 2 + (h)) * HTB)
#define PG8_SB(b, h) ((4 + (b) * 2 + (h)) * HTB)
#define PG8_STAGE(bufoff, gbase, voff) do { _Pragma("unroll") for (int _i = 0; _i < 2; ++_i) \
        __builtin_amdgcn_global_load_lds((const unsigned*)((const char*)(gbase) + (voff)[_i]), (PG8_LAS unsigned*)(lds + (bufoff) + ldsw + _i * 8192), 16, 0, 0); } while (0)
#define PG8_LDA(dst, b, h) do { _Pragma("unroll") for (int m = 0; m < 4; ++m) _Pragma("unroll") for (int k = 0; k < 2; ++k) dst[m][k] = *(const PG8_LAS bf16x8*)(lds + PG8_SA(b, h) + aoff + m * 2048 + k * 1024); } while (0)
#define PG8_LDB(dst, b, h) do { _Pragma("unroll") for (int n = 0; n < 2; ++n) _Pragma("unroll") for (int k = 0; k < 2; ++k) dst[n][k] = *(const PG8_LAS bf16x8*)(lds + PG8_SB(b, h) + boff + n * 2048 + k * 1024); } while (0)
#define PG8_MMA(ai, bj, At, Bt) do { __builtin_amdgcn_s_setprio(1); _Pragma("unroll") for (int m = 0; m < 4; ++m) _Pragma("unroll") for (int n = 0; n < 2; ++n) _Pragma("unroll") for (int k = 0; k < 2; ++k) \
        acc[ai][bj][m][n] = __builtin_amdgcn_mfma_f32_16x16x32_bf16(Bt[n][k], At[m][k], acc[ai][bj][m][n], 0, 0, 0); __builtin_amdgcn_s_setprio(0); } while (0)
#define PG8_WAIT_V(n) asm volatile("s_waitcnt vmcnt(" #n ")" ::: "memory")
#define PG8_WAIT_L(n) asm volatile("s_waitcnt lgkmcnt(" #n ")" ::: "memory")
#define PG8_BAR __builtin_amdgcn_s_barrier()
#define PG8_SCHED __builtin_amdgcn_sched_barrier(0)
    Unit cur, nxt; int ui = 0;
    if (!S.next(0, cur)) return;
    f32x4 acc[2][2][4][2];
#pragma unroll
    for (int a = 0; a < 2; ++a)
#pragma unroll
        for (int b = 0; b < 2; ++b)
#pragma unroll
            for (int m = 0; m < 4; ++m)
#pragma unroll
                for (int n = 0; n < 2; ++n) acc[a][b][m][n] = (f32x4){0.f, 0.f, 0.f, 0.f};
    bf16x8 At[4][2], B0[2][2], B1[2][2];
    const char* cA = (const char*)g.A + (size_t)cur.pm * tstep; const char* cB = (const char*)g.Bt + (size_t)cur.pn * tstep;
    const char* uA = cA; const char* uB = cB;
    S.a_ready(cur);
    if constexpr (SP2) {
        PG8_STAGE(PG8_SB(0, 0), cB, voffB); PG8_STAGE(PG8_SB(0, 1), cB + hstep, voffB); PG8_STAGE(PG8_SA(0, 0), cA, voffA); PG8_STAGE(PG8_SA(0, 1), cA + hstep, voffA);
        if (wr == 1) PG8_BAR;
        PG8_WAIT_V(2); PG8_BAR;
        PG8_STAGE(PG8_SB(1, 0), cB + kstep, voffB); PG8_STAGE(PG8_SA(1, 0), cA + kstep, voffA); PG8_STAGE(PG8_SB(1, 1), cB + hstep + kstep, voffB);
        PG8_WAIT_V(6); PG8_BAR;
    } else {
        PG8_STAGE(PG8_SB(0, 0), cB, voffB); PG8_STAGE(PG8_SA(0, 0), cA, voffA); PG8_STAGE(PG8_SB(0, 1), cB + hstep, voffB); PG8_STAGE(PG8_SA(0, 1), cA + hstep, voffA);
        if (wr == 1) PG8_BAR;
        PG8_WAIT_V(4); PG8_BAR;
        PG8_STAGE(PG8_SB(1, 0), cB + kstep, voffB); PG8_STAGE(PG8_SA(1, 0), cA + kstep, voffA); PG8_STAGE(PG8_SB(1, 1), cB + hstep + kstep, voffB);
        PG8_WAIT_V(6); PG8_BAR;
    }
    for (;;) {
        const bool has_next = S.next(ui + 1, nxt);
        const char* nA = has_next ? (const char*)g.A + (size_t)nxt.pm * tstep : uA; const char* nB = has_next ? (const char*)g.Bt + (size_t)nxt.pn * tstep : uB;
        const char* sA = DUAL ? (const char*)g.A2 + (size_t)cur.pm * tstep : uA; const char* sB = DUAL ? (const char*)g.Bt2 + (size_t)cur.pn * tstep : uB;
        for (int t = 0; t < nt; t += 2) {
            const bool last = (t == nt - 2);
            const bool seam = DUAL && (t == nh - 2);
            if constexpr (DUAL) { if (t == nh) { cA = sA - (size_t)nh * kstep; cB = sB - (size_t)nh * kstep; E.mid(acc, cur, wr, wc, fr, fq); } }
            const char* a1 = cA + (size_t)(t + 1) * kstep;
            const char* a2 = last ? nA : (seam ? sA : cA + (size_t)(t + 2) * kstep); const char* b2 = last ? nB : (seam ? sB : cB + (size_t)(t + 2) * kstep);
            const char* a3 = a2 + kstep; const char* b3 = b2 + kstep;
            if (last && has_next) S.a_ready(nxt);
            if constexpr (SP2) {
            PG8_LDB(B0, 0, 0); PG8_LDB(B1, 0, 1); PG8_SCHED; PG8_LDA(At, 0, 0); PG8_STAGE(PG8_SA(1, 1), a1 + hstep, voffA);
            PG8_WAIT_V(8); PG8_WAIT_L(0); PG8_BAR; PG8_MMA(0, 0, At, B0); PG8_MMA(0, 1, At, B1); PG8_BAR; PG8_SCHED;
            PG8_LDA(At, 0, 1); PG8_STAGE(PG8_SB(0, 0), b2, voffB); PG8_STAGE(PG8_SB(0, 1), b2 + hstep, voffB); PG8_STAGE(PG8_SA(0, 0), a2, voffA);
            PG8_WAIT_V(8); PG8_WAIT_L(0); PG8_BAR; PG8_MMA(1, 0, At, B0); PG8_MMA(1, 1, At, B1); PG8_BAR; PG8_SCHED;
            PG8_LDB(B0, 1, 0); PG8_LDB(B1, 1, 1); PG8_SCHED; PG8_LDA(At, 1, 0); PG8_STAGE(PG8_SA(0, 1), a2 + hstep, voffA);
            PG8_WAIT_V(8); PG8_WAIT_L(0); PG8_BAR; PG8_MMA(0, 0, At, B0); PG8_MMA(0, 1, At, B1); PG8_BAR; PG8_SCHED;
            PG8_LDA(At, 1, 1); PG8_STAGE(PG8_SB(1, 0), b3, voffB); PG8_STAGE(PG8_SB(1, 1), b3 + hstep, voffB); PG8_STAGE(PG8_SA(1, 0), a3, voffA);
            PG8_WAIT_V(8); PG8_WAIT_L(0); PG8_BAR; PG8_MMA(1, 0, At, B0); PG8_MMA(1, 1, At, B1); PG8_BAR; PG8_SCHED;
            } else {
            PG8_LDB(B0, 0, 0); PG8_SCHED; PG8_LDA(At, 0, 0); PG8_STAGE(PG8_SA(1, 1), a1 + hstep, voffA);
            PG8_WAIT_L(8); PG8_BAR; PG8_WAIT_L(0); PG8_MMA(0, 0, At, B0); PG8_BAR; PG8_SCHED;
            PG8_LDB(B1, 0, 1); PG8_STAGE(PG8_SB(0, 0), b2, voffB);
            PG8_BAR; PG8_WAIT_L(0); PG8_MMA(0, 1, At, B1); PG8_BAR;
            PG8_LDA(At, 0, 1); PG8_STAGE(PG8_SA(0, 0), a2, voffA);
            PG8_BAR; PG8_WAIT_L(0); PG8_MMA(1, 0, At, B0); PG8_BAR; PG8_SCHED;
            PG8_STAGE(PG8_SB(0, 1), b2 + hstep, voffB);
            PG8_WAIT_V(6); PG8_BAR; PG8_MMA(1, 1, At, B1); PG8_BAR;
            PG8_LDB(B0, 1, 0); PG8_SCHED; PG8_LDA(At, 1, 0); PG8_STAGE(PG8_SA(0, 1), a2 + hstep, voffA);
            PG8_WAIT_L(8); PG8_BAR; PG8_WAIT_L(0); PG8_MMA(0, 0, At, B0); PG8_BAR; PG8_SCHED;
            PG8_LDB(B1, 1, 1); PG8_STAGE(PG8_SB(1, 0), b3, voffB);
            PG8_BAR; PG8_WAIT_L(0); PG8_MMA(0, 1, At, B1); PG8_BAR;
            PG8_LDA(At, 1, 1); PG8_STAGE(PG8_SA(1, 0), a3, voffA);
            PG8_BAR; PG8_WAIT_L(0); PG8_MMA(1, 0, At, B0); PG8_BAR; PG8_SCHED;
            PG8_STAGE(PG8_SB(1, 1), b3 + hstep, voffB);
            PG8_WAIT_V(6); PG8_BAR; PG8_MMA(1, 1, At, B1); PG8_BAR;
            }
        }
        if constexpr (ALIGN_EPI) { if (wr == 0) PG8_BAR; }
        if constexpr (!Epi::AFTER_DRAIN) { E(acc, cur, wr, wc, fr, fq); S.done(cur); }
        if (!has_next) break;
#pragma unroll
        for (int a = 0; a < 2; ++a)
#pragma unroll
            for (int b = 0; b < 2; ++b)
#pragma unroll
                for (int m = 0; m < 4; ++m)
#pragma unroll
                    for (int n = 0; n < 2; ++n) acc[a][b][m][n] = (f32x4){0.f, 0.f, 0.f, 0.f};
        cur = nxt; cA = nA; cB = nB; uA = nA; uB = nB; ++ui;
        if constexpr (ALIGN_EPI) { if (wr == 1) PG8_BAR; }
    }
    PG8_WAIT_V(0);
    if constexpr (!ALIGN_EPI) { if (wr == 0) PG8_BAR; }
    PG8_BAR;
    if constexpr (Epi::AFTER_DRAIN) { E.fused(acc, cur, wr, wc, fr, fq, lds, wid, lane); S.done(cur); }
#undef PG8_SA
#undef PG8_SB
#undef PG8_STAGE
#undef PG8_LDA
#undef PG8_LDB
#undef PG8_MMA
#undef PG8_WAIT_V
#undef PG8_WAIT_L
#undef PG8_BAR
#undef PG8_SCHED
}
}

namespace pg8 {
#define EPI_ROWS_BEGIN  _Pragma("unroll") for (int ai = 0; ai < 2; ++ai) _Pragma("unroll") for (int m = 0; m < 4; ++m) { const int row = u.pm * BM + ai * HALF + wr * 64 + m * 16 + fr;
#define EPI_ROWS_END    }
__device__ __forceinline__ u32x4 pack8(const f32x4& v0, const f32x4& v1) { u32x4 w; w.x = cvtpk2(v0[0], v0[1]); w.y = cvtpk2(v0[2], v0[3]); w.z = cvtpk2(v1[0], v1[1]); w.w = cvtpk2(v1[2], v1[3]); return w; }
__device__ __forceinline__ void unpack8(const u32x4& w, f32x4& v0, f32x4& v1) { v0[0] = lo_bf(w.x); v0[1] = hi_bf(w.x); v0[2] = lo_bf(w.y); v0[3] = hi_bf(w.y); v1[0] = lo_bf(w.z); v1[1] = hi_bf(w.z); v1[2] = lo_bf(w.w); v1[3] = hi_bf(w.w); }

typedef unsigned u32x2g __attribute__((ext_vector_type(2)));
__device__ __forceinline__ float ub(unsigned w, int k) { return (float)((w >> (8 * k)) & 0xffu); }
struct EpiProj {
    static constexpr bool PERM = true, AFTER_DRAIN = false;
    unsigned char* ws;
    __device__ __forceinline__ void operator()(const f32x4 (&acc)[2][2][4][2], const Unit& u, int wr, int wc, int fr, int fq) const {
        const int pn = u.pn;
        u16* base; int ld, ct;
        if (pn < 16) {
            unsigned char* gb8 = ws + (pn < 8 ? WS_GA : WS_GB); const int c0 = (pn & 7) * BM + wc * 32 + 8 * fq;
            EPI_ROWS_BEGIN
                _Pragma("unroll") for (int bj = 0; bj < 2; ++bj) { unsigned w[2];
                    _Pragma("unroll") for (int n = 0; n < 2; ++n) { unsigned q[4];
                        _Pragma("unroll") for (int j = 0; j < 4; ++j) q[j] = (unsigned)(sigmoidf_(acc[ai][bj][m][n][j]) * 255.f + 0.5f);
                        w[n] = q[0] | (q[1] << 8) | (q[2] << 16) | (q[3] << 24); }
                    u32x2g o; o.x = w[0]; o.y = w[1]; *(u32x2g*)(gb8 + (size_t)row * 2048 + c0 + bj * HALF) = o; }
            EPI_ROWS_END
            return;
        }
        if (pn < 24) { base = (u16*)(ws + WS_Z); ld = 2048; ct = pn - 16; }
        else if (pn < 32) { base = (u16*)(ws + WS_Q); ld = 2048; ct = pn - 24; }
        else if (pn < 34) { base = (u16*)(ws + WS_K); ld = 512; ct = pn - 32; }
        else if (pn < 36) { base = (u16*)(ws + WS_V); ld = 512; ct = pn - 34; }
        else { base = (u16*)(ws + WS_R0); ld = 4096; ct = pn - 36; }
        const int col0 = ct * BM + wc * 32 + 8 * fq;
        EPI_ROWS_BEGIN u16* rowp = base + (size_t)row * ld + col0;
            _Pragma("unroll") for (int bj = 0; bj < 2; ++bj) *(u32x4*)(rowp + bj * HALF) = pack8(acc[ai][bj][m][0], acc[ai][bj][m][1]);
        EPI_ROWS_END
    }
};
#define EPI_ROW(ai, m) (u.pm * BM + (ai) * HALF + wr * 64 + (m) * 16 + fr)
template <int SECOND> struct EpiGate {
    static constexpr bool PERM = true, AFTER_DRAIN = false;
    u16* G; const u16* H;
    __device__ __forceinline__ void operator()(const f32x4 (&acc)[2][2][4][2], const Unit& u, int wr, int wc, int fr, int fq) const {
        const int col0 = u.pn * BM + wc * 32 + 8 * fq;
#pragma unroll
        for (int ai = 0; ai < 2; ++ai) {
            u32x4 gq[4][2], hq[4][2];
#pragma unroll
            for (int m = 0; m < 4; ++m)
#pragma unroll
                for (int bj = 0; bj < 2; ++bj) { const size_t off = (size_t)EPI_ROW(ai, m) * DM + col0 + bj * HALF;
                    gq[m][bj] = *(const u32x4*)(G + off); if (SECOND) hq[m][bj] = *(const u32x4*)(H + off); }
#pragma unroll
            for (int m = 0; m < 4; ++m)
#pragma unroll
                for (int bj = 0; bj < 2; ++bj) { const size_t off = (size_t)EPI_ROW(ai, m) * DM + col0 + bj * HALF;
                    f32x4 g0, g1; unpack8(gq[m][bj], g0, g1); f32x4 r0, r1;
                    if (SECOND == 0) {
#pragma unroll
                        for (int j = 0; j < 4; ++j) { r0[j] = sigmoidf_(g0[j]) * acc[ai][bj][m][0][j]; r1[j] = sigmoidf_(g1[j]) * acc[ai][bj][m][1][j]; } }
                    else { f32x4 h0, h1; unpack8(hq[m][bj], h0, h1);
#pragma unroll
                        for (int j = 0; j < 4; ++j) { r0[j] = g0[j] + sigmoidf_(h0[j]) * acc[ai][bj][m][0][j]; r1[j] = g1[j] + sigmoidf_(h1[j]) * acc[ai][bj][m][1][j]; } }
                    *(u32x4*)(G + off) = pack8(r0, r1); }
        }
    }
};
struct EpiGate2 {
    static constexpr bool PERM = true, AFTER_DRAIN = false;
    const unsigned char* SA; const unsigned char* SB; u16* MG;
    __device__ __forceinline__ void mid(f32x4 (&acc)[2][2][4][2], const Unit& u, int wr_, int wc_, int fr_, int fq_) const {
        const int ot = opaque_tid(), wr = __builtin_amdgcn_readfirstlane(ot >> 8), wc = __builtin_amdgcn_readfirstlane((ot >> 6) & 3), fr = ot & 15, fq = (ot >> 4) & 3;
        const int col0 = u.pn * BM + wc * 32 + 8 * fq;
#pragma unroll
        for (int ai = 0; ai < 2; ++ai) {
            u32x2g aq[4][2], bq[4][2];
#pragma unroll
            for (int m = 0; m < 4; ++m)
#pragma unroll
                for (int bj = 0; bj < 2; ++bj) { const size_t off = (size_t)EPI_ROW(ai, m) * 2048 + col0 + bj * HALF; aq[m][bj] = *(const u32x2g*)(SA + off); bq[m][bj] = *(const u32x2g*)(SB + off); }
#pragma unroll
            for (int m = 0; m < 4; ++m)
#pragma unroll
                for (int bj = 0; bj < 2; ++bj)
#pragma unroll
                    for (int j = 0; j < 4; ++j) { acc[ai][bj][m][0][j] *= ub(aq[m][bj].x, j) * __builtin_amdgcn_rcpf(fmaxf(ub(bq[m][bj].x, j), 0.5f));
                                                  acc[ai][bj][m][1][j] *= ub(aq[m][bj].y, j) * __builtin_amdgcn_rcpf(fmaxf(ub(bq[m][bj].y, j), 0.5f)); }
        }
    }
    __device__ __forceinline__ void operator()(const f32x4 (&acc)[2][2][4][2], const Unit& u, int wr_, int wc_, int fr_, int fq_) const {
        const int ot = opaque_tid(), wr = __builtin_amdgcn_readfirstlane(ot >> 8), wc = __builtin_amdgcn_readfirstlane((ot >> 6) & 3), fr = ot & 15, fq = (ot >> 4) & 3;
        const int col0 = u.pn * BM + wc * 32 + 8 * fq;
#pragma unroll
        for (int ai = 0; ai < 2; ++ai) {
            u32x2g bq[4][2];
#pragma unroll
            for (int m = 0; m < 4; ++m)
#pragma unroll
                for (int bj = 0; bj < 2; ++bj) bq[m][bj] = *(const u32x2g*)(SB + (size_t)EPI_ROW(ai, m) * 2048 + col0 + bj * HALF);
#pragma unroll
            for (int m = 0; m < 4; ++m)
#pragma unroll
                for (int bj = 0; bj < 2; ++bj) { f32x4 r0, r1;
#pragma unroll
                    for (int j = 0; j < 4; ++j) { r0[j] = fmaxf(ub(bq[m][bj].x, j), 0.5f) * (1.f / 255.f) * acc[ai][bj][m][0][j]; r1[j] = fmaxf(ub(bq[m][bj].y, j), 0.5f) * (1.f / 255.f) * acc[ai][bj][m][1][j]; }
                    *(u32x4*)(MG + (size_t)EPI_ROW(ai, m) * DM + col0 + bj * HALF) = pack8(r0, r1); }
        }
    }
};
struct EpiRes {
    static constexpr bool PERM = true, AFTER_DRAIN = false;
    const float* R32; float* O32; u16* O16; float* ssq;
    __device__ __forceinline__ void operator()(const f32x4 (&acc)[2][2][4][2], const Unit& u, int wr, int wc, int fr, int fq) const {
        const int col0 = u.pn * BM + wc * 32 + 8 * fq;
#pragma unroll
        for (int ai = 0; ai < 2; ++ai) {
            f32x4 rq[4][2][2];
#pragma unroll
            for (int m = 0; m < 4; ++m)
#pragma unroll
                for (int bj = 0; bj < 2; ++bj) { const size_t off = (size_t)EPI_ROW(ai, m) * DM + col0 + bj * HALF; rq[m][bj][0] = *(const f32x4*)(R32 + off); rq[m][bj][1] = *(const f32x4*)(R32 + off + 4); }
#pragma unroll
            for (int m = 0; m < 4; ++m) { const int row = EPI_ROW(ai, m); float s = 0.f;
#pragma unroll
                for (int bj = 0; bj < 2; ++bj) { const size_t off = (size_t)row * DM + col0 + bj * HALF;
                    const f32x4 r0 = rq[m][bj][0] + acc[ai][bj][m][0], r1 = rq[m][bj][1] + acc[ai][bj][m][1];
                    *(f32x4*)(O32 + off) = r0; *(f32x4*)(O32 + off + 4) = r1;
                    if (O16) *(u32x4*)(O16 + off) = pack8(r0, r1);
#pragma unroll
                    for (int j = 0; j < 4; ++j) s += r0[j] * r0[j] + r1[j] * r1[j]; }
                s += __shfl_xor(s, 16); s += __shfl_xor(s, 32);
                if (fq == 0) ssq[(size_t)row * 32 + u.pn * 4 + wc] = s; }
        }
    }
};
template <int MODE> struct EpiResB {
    static constexpr bool PERM = true, AFTER_DRAIN = false;
    const float* R32; u16* X16; float* ssq;
    __device__ __forceinline__ void operator()(const f32x4 (&acc)[2][2][4][2], const Unit& u, int wr, int wc, int fr, int fq) const {
        const int col0 = u.pn * BM + wc * 32 + 8 * fq;
#pragma unroll
        for (int ai = 0; ai < 2; ++ai) {
            f32x4 rq[4][2][2];
#pragma unroll
            for (int m = 0; m < 4; ++m)
#pragma unroll
                for (int bj = 0; bj < 2; ++bj) { const size_t off = (size_t)EPI_ROW(ai, m) * DM + col0 + bj * HALF;
                    if (MODE == 0) { rq[m][bj][0] = *(const f32x4*)(R32 + off); rq[m][bj][1] = *(const f32x4*)(R32 + off + 4); }
                    else unpack8(*(const u32x4*)(X16 + off), rq[m][bj][0], rq[m][bj][1]); }
#pragma unroll
            for (int m = 0; m < 4; ++m) { const int row = EPI_ROW(ai, m); float s = 0.f;
#pragma unroll
                for (int bj = 0; bj < 2; ++bj) { const size_t off = (size_t)row * DM + col0 + bj * HALF;
                    const f32x4 r0 = rq[m][bj][0] + acc[ai][bj][m][0], r1 = rq[m][bj][1] + acc[ai][bj][m][1];
                    *(u32x4*)(X16 + off) = pack8(r0, r1);
#pragma unroll
                    for (int j = 0; j < 4; ++j) s += r0[j] * r0[j] + r1[j] * r1[j]; }
                s += __shfl_xor(s, 16); s += __shfl_xor(s, 32);
                if (fq == 0) ssq[(size_t)row * 32 + u.pn * 4 + wc] = s; }
        }
    }
};
struct EpiMlpIn {
    static constexpr bool PERM = true, AFTER_DRAIN = false;
    u16* U; const float* ssq;
    __device__ __forceinline__ void operator()(const f32x4 (&acc)[2][2][4][2], const Unit& u, int wr, int wc, int fr, int fq) const {
        const int col0 = u.pn * BM + wc * 32 + 8 * fq;
        f32x4 pq[2][4][2];
#pragma unroll
        for (int ai = 0; ai < 2; ++ai)
#pragma unroll
            for (int m = 0; m < 4; ++m) { const float* sp = ssq + (size_t)EPI_ROW(ai, m) * 32 + fq * 8; pq[ai][m][0] = *(const f32x4*)sp; pq[ai][m][1] = *(const f32x4*)(sp + 4); }
#pragma unroll
        for (int ai = 0; ai < 2; ++ai)
#pragma unroll
            for (int m = 0; m < 4; ++m) { const int row = EPI_ROW(ai, m);
                const f32x4 p0 = pq[ai][m][0], p1 = pq[ai][m][1];
                float s = (p0[0] + p0[1]) + (p0[2] + p0[3]) + (p1[0] + p1[1]) + (p1[2] + p1[3]);
                s += __shfl_xor(s, 16); s += __shfl_xor(s, 32);
                const float rstd = __builtin_amdgcn_rsqf(s * (1.f / DM) + EPSN);
#pragma unroll
                for (int bj = 0; bj < 2; ++bj) { f32x4 r0, r1;
#pragma unroll
                    for (int j = 0; j < 4; ++j) { const float a = fmaxf(acc[ai][bj][m][0][j] * rstd, 0.f), b = fmaxf(acc[ai][bj][m][1][j] * rstd, 0.f); r0[j] = a * a; r1[j] = b * b; }
                    *(u32x4*)(U + (size_t)row * DFF + col0 + bj * HALF) = pack8(r0, r1); } }
    }
};
}

#define XB_TMO      128
#define XB_XCNT(j)  (256  + 64 * (j))
#define XB_XSUB(j)  (1280 + 64 * (j))
#define XB_XGEN(j)  (2304 + 64 * (j))
#define XB_TOP      3328
#define XB_TOPGEN   3392
#define XCD_BAR_WORDS 3456
#define XB_SPIN_CAP (1u << 18)
#define LAS __attribute__((address_space(3)))

__device__ __forceinline__ unsigned xb_ld(unsigned* p)              { return __hip_atomic_load(p, __ATOMIC_RELAXED, __HIP_MEMORY_SCOPE_AGENT); }
__device__ __forceinline__ unsigned xb_add(unsigned* p, unsigned v) { return __hip_atomic_fetch_add(p, v, __ATOMIC_RELAXED, __HIP_MEMORY_SCOPE_AGENT); }
__device__ __forceinline__ unsigned xb_xcc_id() { return (unsigned)__builtin_amdgcn_s_getreg((3 << 11) | 20) & 0xFu; }
#define XB_SPIN(cond, bar) do { unsigned _sp = 0; while (cond) { __builtin_amdgcn_s_sleep(1); \
    if ((++_sp & 255u) == 0u) { if (xb_ld(&(bar)[XB_TMO])) break; if (_sp > XB_SPIN_CAP) { atomicAdd(&(bar)[XB_TMO], 1u); break; } } } } while (0)

struct XcdBarrier {
    unsigned* bar; unsigned x;
    volatile LAS unsigned* st;
};

__device__ __forceinline__ XcdBarrier xcd_barrier_post(unsigned* bar, volatile LAS unsigned* st) {
    XcdBarrier b; b.bar = bar; b.x = xb_xcc_id(); b.st = st;
    if (threadIdx.x == 0) (void)xb_add(&bar[XB_XCNT(b.x)], 1u);
    return b;
}
__device__ __forceinline__ void xcd_barrier_complete(unsigned* bar, unsigned x, unsigned& nloc, unsigned& nx) {
    const unsigned G = gridDim.x * gridDim.y * gridDim.z;
    unsigned sum, cnt, mine, sp = 0u;
    for (;;) {
        sum = 0u; cnt = 0u; mine = 0u;
#pragma unroll
        for (unsigned j = 0; j < 16; ++j) { const unsigned c = xb_ld(&bar[XB_XCNT(j)]); sum += c; cnt += (c > 0u) ? 1u : 0u; mine = (j == x) ? c : mine; }
        if (sum == G) break;
        __builtin_amdgcn_s_sleep(1);
        if ((++sp & 255u) == 0u) { if (xb_ld(&bar[XB_TMO])) break; if (sp > XB_SPIN_CAP) { atomicAdd(&bar[XB_TMO], 1u); break; } }
    }
    nloc = mine > 0u ? mine : 1u; nx = cnt > 0u ? cnt : 1u;
}

__device__ __forceinline__ void xcd_barrier(const XcdBarrier& b) {
    asm volatile("s_waitcnt vmcnt(0)" ::: "memory");
    __syncthreads();
    if (threadIdx.x == 0) {
        unsigned* bar = b.bar;
        __builtin_amdgcn_s_waitcnt(0);
        unsigned nloc = b.st[0], nx = b.st[1];
        if (nloc == 0u) { xcd_barrier_complete(bar, b.x, nloc, nx); b.st[0] = nloc; b.st[1] = nx; }
        const unsigned old = xb_add(&bar[XB_XSUB(b.x)], 1u);
        const unsigned gen = old / nloc;
        if (old + 1u == (gen + 1u) * nloc) {
            __builtin_amdgcn_fence(__ATOMIC_RELEASE, "agent");
            asm volatile("s_waitcnt vmcnt(0)" ::: "memory");
            const unsigned og = xb_add(&bar[XB_TOP], 1u);
            const unsigned tg = og / nx;
            if (og + 1u == (tg + 1u) * nx) xb_add(&bar[XB_TOPGEN], 1u);
            else XB_SPIN(xb_ld(&bar[XB_TOPGEN]) == tg, bar);
            __builtin_amdgcn_fence(__ATOMIC_ACQUIRE, "agent");
            xb_add(&bar[XB_XGEN(b.x)], 1u);
            asm volatile("s_waitcnt vmcnt(0)" ::: "memory");
        } else {
            XB_SPIN(xb_ld(&bar[XB_XGEN(b.x)]) == gen, bar);
            __builtin_amdgcn_fence(__ATOMIC_ACQUIRE, "agent");
            asm volatile("s_waitcnt vmcnt(0)" ::: "memory");
        }
    }
    __syncthreads();
}


__device__ __forceinline__ void panel_sync(unsigned* cnt, unsigned need) {
    asm volatile("s_waitcnt vmcnt(0)" ::: "memory");
    __syncthreads();
    if (threadIdx.x == 0) {
        __builtin_amdgcn_s_waitcnt(0);
        __builtin_amdgcn_fence(__ATOMIC_RELEASE, "agent");
        asm volatile("s_waitcnt vmcnt(0)" ::: "memory");
        (void)xb_add(cnt, 1u);
        unsigned sp = 0u;
        while (xb_ld(cnt) < need) { __builtin_amdgcn_s_sleep(1); if (++sp > (1u << 20)) break; }
        __builtin_amdgcn_fence(__ATOMIC_ACQUIRE, "agent");
        asm volatile("s_waitcnt vmcnt(0)" ::: "memory");
    }
    __syncthreads();
}
namespace att {
using bf16 = __hip_bfloat16;
constexpr int   D = 128, NW = 8, QBLK = 32, KVBLK = 64;
constexpr float SCALE = 0.088388347648318440f;
constexpr float THR = 8.f;
constexpr int SDEPTH = 2;
constexpr int LDQ = 2048, LDK = 512, LDO = 2048;
constexpr size_t SHM_V = KVBLK * D * 2, SHM_K = KVBLK * D * 2, SHM_ATTN = 2 * SHM_V + 2 * SHM_K + NW * 64 * 4;
using bf16x8 = __attribute__((ext_vector_type(8))) short;
using s16x4  = __attribute__((ext_vector_type(4))) short;
using f32x16 = __attribute__((ext_vector_type(16))) float;
using f32x8  = __attribute__((ext_vector_type(8))) float;
using u32x4  = __attribute__((ext_vector_type(4))) unsigned;
#define KSWZ(row, colB) ((row) * 256 + ((colB) ^ (((row) & 7) << 4)))
#define SBAR() __builtin_amdgcn_sched_barrier(0)
__device__ __forceinline__ int crow(int r, int hi) { return (r & 3) + 8 * (r >> 2) + 4 * hi; }
__device__ __forceinline__ unsigned cvtpk(float lo, float hi) {
  unsigned r; asm volatile("v_cvt_pk_bf16_f32 %0, %1, %2" : "=v"(r) : "v"(lo), "v"(hi)); return r;
}
template <typename TIn> struct Stage;
template <> struct Stage<bf16>  { using T = bf16x8;
  __device__ static __forceinline__ T ld8(const bf16* p) { return *reinterpret_cast<const bf16x8*>(p); }
  __device__ static __forceinline__ bf16x8 tobf(T x) { return x; } };
template <> struct Stage<float> { using T = f32x8;
  __device__ static __forceinline__ T ld8(const float* p) { return *reinterpret_cast<const f32x8*>(p); }
  __device__ static __forceinline__ bf16x8 tobf(T x) {
    u32x4 w = {cvtpk(x[0], x[1]), cvtpk(x[2], x[3]), cvtpk(x[4], x[5]), cvtpk(x[6], x[7])}; return *reinterpret_cast<bf16x8*>(&w); } };

__device__ __forceinline__ void partialSM(f32x16& p0, f32x16& p1, float& m_reg, float& mn, float& alpha) {
  constexpr float C = SCALE * 1.4426950408889634f;
  float pmax = p0[0]; for (int r = 1; r < 16; ++r) pmax = fmaxf(pmax, p0[r]); for (int r = 0; r < 16; ++r) pmax = fmaxf(pmax, p1[r]);
  { auto rr = __builtin_amdgcn_permlane32_swap(__float_as_uint(pmax), __float_as_uint(pmax), false, false);
    pmax = fmaxf(__uint_as_float(rr[0]), __uint_as_float(rr[1])); }
  if (__builtin_expect(__all(pmax - m_reg <= THR / SCALE), 1)) { mn = m_reg; alpha = 1.f; }
  else { mn = fmaxf(m_reg, pmax); alpha = __builtin_amdgcn_exp2f((m_reg - mn) * C); m_reg = mn; }
  float mnC = -mn * C;
  for (int r = 0; r < 16; ++r) p0[r] = fmaf(p0[r], C, mnC); for (int r = 0; r < 16; ++r) p1[r] = fmaf(p1[r], C, mnC);
  for (int r = 0; r < 16; ++r) p0[r] = __builtin_amdgcn_exp2f(p0[r]);
}
__device__ __forceinline__ void finishSM(f32x16& p0, f32x16& p1, float alpha, float& l_reg, bf16x8& pa0, bf16x8& pa1, bf16x8& pa2, bf16x8& pa3) {
  for (int r = 0; r < 16; ++r) p1[r] = __builtin_amdgcn_exp2f(p1[r]);
  float ps = 0; for (int r = 0; r < 16; ++r) ps += p0[r]; for (int r = 0; r < 16; ++r) ps += p1[r];
  { auto rr = __builtin_amdgcn_permlane32_swap(__float_as_uint(ps), __float_as_uint(ps), false, false);
    ps = __uint_as_float(rr[0]) + __uint_as_float(rr[1]); }
  l_reg = l_reg * alpha + ps;
#define PK4(P, BASE, OUT) do { unsigned a0 = cvtpk(P[BASE + 0], P[BASE + 1]), a1 = cvtpk(P[BASE + 2], P[BASE + 3]);   \
    unsigned b0 = cvtpk(P[BASE + 4], P[BASE + 5]), b1 = cvtpk(P[BASE + 6], P[BASE + 7]);                              \
    auto r0 = __builtin_amdgcn_permlane32_swap(a0, b0, false, false); auto r1 = __builtin_amdgcn_permlane32_swap(a1, b1, false, false); \
    u32x4 w = {r0[0], r1[0], r0[1], r1[1]}; OUT = *reinterpret_cast<bf16x8*>(&w); } while (0)
  PK4(p0, 0, pa0); PK4(p0, 8, pa1); PK4(p1, 0, pa2); PK4(p1, 8, pa3);
#undef PK4
}
__device__ __forceinline__ void qkt(f32x16& p0, f32x16& p1, const bf16* Ks, const bf16x8* qr, int r32, int hi) {
  p0 = f32x16{}; p1 = f32x16{};
  for (int d0 = 0; d0 < 8; ++d0) { int cb = (d0 * 16 + hi * 8) * 2;
    bf16x8 b0 = *reinterpret_cast<const bf16x8*>((const char*)Ks + KSWZ(r32, cb));
    bf16x8 b1 = *reinterpret_cast<const bf16x8*>((const char*)Ks + KSWZ(32 + r32, cb));
    p0 = __builtin_amdgcn_mfma_f32_32x32x16_bf16(b0, qr[d0], p0, 0, 0, 0);
    p1 = __builtin_amdgcn_mfma_f32_32x32x16_bf16(b1, qr[d0], p1, 0, 0, 0); }
}
__device__ __forceinline__ int v_st(int k, int c) { const int kk = (k & ~0xC) | ((k & 4) << 1) | ((k & 8) >> 1); return ((kk >> 3) * 4 + (c >> 5)) * 512 + ((kk & 7) * 32 + (c & 31)) * 2; }
__device__ __forceinline__ int v_rd_base(int lane) { return ((lane & 3) << 3) | (((lane >> 2) & 3) << 6) | (((lane >> 4) & 1) << 5) | (((lane >> 5) & 1) << 8); }
constexpr int v_rd_off(int d0, int ks, int half) { return d0 * 512 + ks * 4096 + half * 2048; }
template <int OFF> __device__ __forceinline__ s16x4 tr_read(int vb) {
  s16x4 r; asm volatile("ds_read_b64_tr_b16 %0, %1 offset:%2" : "=&v"(r) : "v"(vb), "i"(OFF) : "memory"); return r;
}
template <int D0> __device__ __forceinline__ void pv_one(f32x16& od, int vb, bf16x8 pa0, bf16x8 pa1, bf16x8 pa2, bf16x8 pa3) {
  const s16x4 l0 = tr_read<v_rd_off(D0, 0, 0)>(vb), h0 = tr_read<v_rd_off(D0, 0, 1)>(vb), l1 = tr_read<v_rd_off(D0, 1, 0)>(vb), h1 = tr_read<v_rd_off(D0, 1, 1)>(vb);
  const s16x4 l2 = tr_read<v_rd_off(D0, 2, 0)>(vb), h2 = tr_read<v_rd_off(D0, 2, 1)>(vb), l3 = tr_read<v_rd_off(D0, 3, 0)>(vb), h3 = tr_read<v_rd_off(D0, 3, 1)>(vb);
  asm volatile("s_waitcnt lgkmcnt(0)" ::: "memory"); SBAR();
#define PK(L, H) (bf16x8){L[0], L[1], L[2], L[3], H[0], H[1], H[2], H[3]}
  od = __builtin_amdgcn_mfma_f32_32x32x16_bf16(pa0, PK(l0, h0), od, 0, 0, 0);
  od = __builtin_amdgcn_mfma_f32_32x32x16_bf16(pa1, PK(l1, h1), od, 0, 0, 0);
  od = __builtin_amdgcn_mfma_f32_32x32x16_bf16(pa2, PK(l2, h2), od, 0, 0, 0);
  od = __builtin_amdgcn_mfma_f32_32x32x16_bf16(pa3, PK(l3, h3), od, 0, 0, 0);
#undef PK
}
__device__ __forceinline__ void pv_d0(f32x16* o, int vb, bf16x8 pa0, bf16x8 pa1, bf16x8 pa2, bf16x8 pa3) {
  pv_one<0>(o[0], vb, pa0, pa1, pa2, pa3); pv_one<1>(o[1], vb, pa0, pa1, pa2, pa3); pv_one<2>(o[2], vb, pa0, pa1, pa2, pa3); pv_one<3>(o[3], vb, pa0, pa1, pa2, pa3);
}

template <typename TQ>
__device__ __forceinline__ void attn_dense_body(const TQ* __restrict__ Qb, const bf16* __restrict__ Kh, const bf16* __restrict__ Vh,
                                                bf16* __restrict__ Ob, int seq, char* lds, const float* __restrict__ qg, const float* __restrict__ rtab, int spos0) {
  using St = Stage<bf16>; using SQ = Stage<TQ>;
  const int tid = opaque_tid(), wid = tid >> 6, lane = tid & 63, r32 = lane & 31, hi = lane >> 5;
  bf16* V_lds = (bf16*)lds; bf16* K_lds = (bf16*)(lds + 2 * SHM_V);
  float* ws = (float*)(lds + 2 * SHM_V + 2 * SHM_K) + wid * 64; float* li_l = ws; float* al_l = ws + 32;
  float m_reg = -1e30f, l_reg = 0; f32x16 o[4] = {}; bf16x8 qr[8];
  const TQ* Qw = Qb + (long)(wid * QBLK + r32) * LDQ + hi * 8;
#pragma unroll
  for (int d0 = 0; d0 < 8; ++d0) qr[d0] = SQ::tobf(SQ::ld8(Qw + d0 * 16));
  {
    float ssq = 0.f;
#pragma unroll
    for (int d0 = 0; d0 < 8; ++d0) { const u32x4 w = *reinterpret_cast<const u32x4*>(&qr[d0]);
#pragma unroll
      for (int e = 0; e < 4; ++e) { const float lo = __uint_as_float(w[e] << 16), hi2 = __uint_as_float(w[e] & 0xffff0000u); ssq += lo * lo + hi2 * hi2; } }
    ssq += __shfl_xor(ssq, 32);
    const float rstd = __builtin_amdgcn_rsqf(ssq * (1.f / 128.f) + 1e-6f);
    const int pos = spos0 + wid * QBLK + r32, prow = pos >> 6, pcol = pos & 63;
#pragma unroll
    for (int d0 = 0; d0 < 8; ++d0) { const int e0 = d0 * 16 + hi * 8, pv = d0 < 4 ? prow : pcol, j0 = (d0 & 3) * 8 + hi * 4;
      const f32x8 g = *reinterpret_cast<const f32x8*>(qg + e0); const f32x8 cs = *reinterpret_cast<const f32x8*>(rtab + (pv * 32 + j0) * 2);
      const u32x4 w = *reinterpret_cast<const u32x4*>(&qr[d0]); u32x4 o;
#pragma unroll
      for (int e = 0; e < 4; ++e) { const float x0 = __uint_as_float(w[e] << 16) * rstd * g[2 * e], x1 = __uint_as_float(w[e] & 0xffff0000u) * rstd * g[2 * e + 1];
        const float c = cs[2 * e], s = cs[2 * e + 1]; o[e] = cvtpk(x0 * c - x1 * s, x0 * s + x1 * c); }
      qr[d0] = *reinterpret_cast<bf16x8*>(&o); } }
  const int sr = tid >> 4, sc = (tid & 15) * 8, vst0 = v_st(sr, sc), vst1 = v_st(32 + sr, sc);
  const int vb0 = (int)(uintptr_t)V_lds + v_rd_base(lane);
  struct { typename St::T vs0, vs1, ks0, ks1; } sr_[SDEPTH];
#define SLOAD(i, k0) do { sr_[i].vs0 = St::ld8(&Vh[(long)((k0) + sr) * LDK + sc]); sr_[i].vs1 = St::ld8(&Vh[(long)((k0) + 32 + sr) * LDK + sc]); \
    sr_[i].ks0 = St::ld8(&Kh[(long)((k0) + sr) * LDK + sc]); sr_[i].ks1 = St::ld8(&Kh[(long)((k0) + 32 + sr) * LDK + sc]); } while (0)
#define SWRITE(b, i) do { *(bf16x8*)((char*)V_lds + (b) * SHM_V + vst0) = St::tobf(sr_[i].vs0);          \
    *(bf16x8*)((char*)V_lds + (b) * SHM_V + vst1) = St::tobf(sr_[i].vs1); int kc = sc * 2;               \
    *(bf16x8*)((char*)K_lds + (b) * SHM_K + KSWZ(sr, kc)) = St::tobf(sr_[i].ks0);                       \
    *(bf16x8*)((char*)K_lds + (b) * SHM_K + KSWZ(32 + sr, kc)) = St::tobf(sr_[i].ks1); } while (0)
#define SWAIT() do { if constexpr (SDEPTH == 2) asm volatile("s_waitcnt vmcnt(4)" ::: "memory"); else asm volatile("s_waitcnt vmcnt(0)" ::: "memory"); } while (0)
#define RESC(a) do { if (__any((a) < 1.f)) { if (hi == 0) al_l[r32] = (a); asm volatile("s_waitcnt lgkmcnt(0)" ::: "memory"); \
    for (int d = 0; d < 4; ++d) for (int r = 0; r < 16; ++r) o[d][r] *= al_l[crow(r, hi)]; } } while (0)
  f32x16 pA0, pA1, pB0, pB1; float mnA, mnB, alA, alB; bf16x8 pa0, pa1, pa2, pa3; const int NT = seq / KVBLK;
  constexpr int SE = 0, SO = SDEPTH - 1;
  SLOAD(SE, 0); asm volatile("s_waitcnt vmcnt(0)" ::: "memory"); SWRITE(0, SE); __syncthreads();
  qkt(pA0, pA1, K_lds, qr, r32, hi); partialSM(pA0, pA1, m_reg, mnA, alA);
  SLOAD(SO, KVBLK); if constexpr (SDEPTH == 2) { if (2 < NT) SLOAD(SE, 2 * KVBLK); }
  SWAIT(); SWRITE(1, SO); __syncthreads();
  for (int j = 1; j + 1 < NT; j += 2) {
    SBAR(); qkt(pB0, pB1, (bf16*)((char*)K_lds + SHM_K), qr, r32, hi);
    finishSM(pA0, pA1, alA, l_reg, pa0, pa1, pa2, pa3); SBAR();
    SLOAD(SO, (j + SDEPTH) * KVBLK); SBAR();
    pv_d0(o, vb0, pa0, pa1, pa2, pa3); partialSM(pB0, pB1, m_reg, mnB, alB);
    __syncthreads(); SWAIT(); SWRITE(0, SE);
    RESC(alB); __syncthreads();
    SBAR(); qkt(pA0, pA1, K_lds, qr, r32, hi);
    finishSM(pB0, pB1, alB, l_reg, pa0, pa1, pa2, pa3); SBAR();
    if (SDEPTH == 1 || j + 3 < NT) SLOAD(SE, (j + 1 + SDEPTH) * KVBLK); SBAR();
    pv_d0(o, vb0 + (int)SHM_V, pa0, pa1, pa2, pa3); partialSM(pA0, pA1, m_reg, mnA, alA);
    __syncthreads(); SWAIT(); SWRITE(1, SO);
    RESC(alA); __syncthreads();
  }
  SBAR(); qkt(pB0, pB1, (bf16*)((char*)K_lds + SHM_K), qr, r32, hi);
  finishSM(pA0, pA1, alA, l_reg, pa0, pa1, pa2, pa3); SBAR();
  pv_d0(o, vb0, pa0, pa1, pa2, pa3); partialSM(pB0, pB1, m_reg, mnB, alB);
  __syncthreads(); RESC(alB);
  finishSM(pB0, pB1, alB, l_reg, pa0, pa1, pa2, pa3); SBAR();
  pv_d0(o, vb0 + (int)SHM_V, pa0, pa1, pa2, pa3);
  if (hi == 0) li_l[r32] = l_reg; asm volatile("s_waitcnt lgkmcnt(0)" ::: "memory");
  float rli[16];
#pragma unroll
  for (int r = 0; r < 16; ++r) rli[r] = __builtin_amdgcn_rcpf(li_l[crow(r, hi)]);
  bf16* Ow = Ob + (long)(wid * QBLK) * LDO;
#pragma unroll
  for (int r = 0; r < 16; ++r) { int orow = crow(r, hi);
    for (int d0 = 0; d0 < 4; ++d0) { unsigned uu = __float_as_uint(o[d0][r] * rli[r]); uu += 0x7fffu + ((uu >> 16) & 1u); ((unsigned short*)Ow)[(long)orow * LDO + d0 * 32 + r32] = (unsigned short)(uu >> 16); } }
#undef SLOAD
#undef SWRITE
#undef SWAIT
#undef RESC
}
}
typedef short bf16x8v __attribute__((ext_vector_type(8)));
typedef float f32x4v __attribute__((ext_vector_type(4)));
typedef unsigned u32x4v __attribute__((ext_vector_type(4)));
#define MFMA16(a, b, c) __builtin_amdgcn_mfma_f32_16x16x32_bf16((a), (b), (c), 0, 0, 0)
__device__ __forceinline__ s16x4v tr_read16(const unsigned char* p) { return __builtin_amdgcn_ds_read_tr16_b64_v4i16((LAS3 s16x4v*)(p)); }
__device__ __forceinline__ bf16x8v pack_bf8(const float* m) { u32x4v w; w.x = cvtpk2(m[0], m[1]); w.y = cvtpk2(m[2], m[3]); w.z = cvtpk2(m[4], m[5]); w.w = cvtpk2(m[6], m[7]); return *reinterpret_cast<bf16x8v*>(&w); }
__device__ __forceinline__ void unpack_bf8(u32x4v w, float* f) { f[0] = lo_bf(w.x); f[1] = hi_bf(w.x); f[2] = lo_bf(w.y); f[3] = hi_bf(w.y); f[4] = lo_bf(w.z); f[5] = hi_bf(w.z); f[6] = lo_bf(w.w); f[7] = hi_bf(w.w); }

__device__ __forceinline__ int win_dest_row(int n) {
    if (n < 2048) return 4096 + n;
    if (n < 6144) return 9216 + (n - 2048);
    if (n < 6208) return 13312 + (n - 6144);
    if (n < 8256) return 6144 + (n - 6208);
    if (n < 8768) return 8192 + (n - 8256);
    if (n < 9280) return 8704 + (n - 8768);
    if (n < 11328) return n - 9280;
    return 2048 + (n - 11328);
}
struct WtDesc { const float* W; u16* Wt; const float* ks; int N, K, k0, n0, drow0; };
__device__ __forceinline__ void wt_load(const WtDesc& d, f32x4v (&v)[4]) {
    const int tid = opaque_tid(), kr = tid >> 3, c4 = tid & 7;
#pragma unroll
    for (int i = 0; i < 4; ++i) { const int k = d.k0 + kr + 64 * i; v[i] = __builtin_nontemporal_load((const f32x4v*)(d.W + (size_t)k * d.N + d.n0 + c4 * 4)); if (d.ks) { const float s = d.ks[k]; v[i] *= s; } }
}
__device__ __forceinline__ void wt_to_lds(const f32x4v (&v)[4], u16* L) {
    const int tid = opaque_tid(), kr = tid >> 3, c4 = tid & 7;
#pragma unroll
    for (int i = 0; i < 4; ++i) { const int kl = kr + 64 * i, ksw = kl ^ ((c4 >> 1) << 3);
#pragma unroll
        for (int e = 0; e < 4; ++e) L[(c4 * 4 + e) * 264 + ksw] = f2bf(v[i][e]); }
}
__device__ __forceinline__ void wt_from_lds(const WtDesc& d, const u16* L) {
    const int tid = opaque_tid(), n = tid >> 4, kk = tid & 15, sw = (n >> 3) & 3;
    const u32x4v a = *(const u32x4v*)(L + n * 264 + (((2 * kk) ^ sw) << 3));
    const u32x4v b = *(const u32x4v*)(L + n * 264 + (((2 * kk + 1) ^ sw) << 3));
    u16* dst = d.Wt + (size_t)(d.drow0 + n) * d.K + d.k0 + kk * 16;
    *(u32x4v*)dst = a; *(u32x4v*)(dst + 8) = b;
}
__device__ __forceinline__ WtDesc wt_desc_prep(const Params& P, int it) {
    unsigned char* ws = P.ws; unsigned char* dob = (unsigned char*)P.out; WtDesc d; d.ks = nullptr;
    if (it < 3344) { const int nt = it >> 3, kt = it & 7; d.W = P.w_in; d.N = NIN; d.K = DM; d.Wt = (u16*)(dob + DO_WIN); d.k0 = kt * 256; d.n0 = nt * 32; d.drow0 = win_dest_row(nt * 32); }
    else { const int j = it - 3344, mat = j >> 9, r = j & 511, nt = r >> 3, kt = r & 7;
        d.W = mat == 0 ? P.w_ssm_up : (mat == 1 ? P.w_attn_up : P.w_out); d.Wt = (u16*)(ws + (mat == 0 ? WS_WSSM : (mat == 1 ? WS_WATT : WS_WOUT)));
        d.N = DM; d.K = DM; d.k0 = kt * 256; d.n0 = nt * 32; d.drow0 = nt * 32; }
    return d;
}
__device__ __forceinline__ WtDesc wt_desc_w1(const Params& P, int it) {
    WtDesc d; const int nt = it >> 3, kt = it & 7; d.W = P.w_mlp_in; d.Wt = (u16*)(P.ws + WS_W1T); d.ks = P.g_mlp; d.N = DFF; d.K = DM; d.k0 = kt * 256; d.n0 = nt * 32; d.drow0 = nt * 32; return d;
}
__device__ __forceinline__ WtDesc wt_desc_w2(const Params& P, int it) {
    WtDesc d; d.ks = nullptr; const int nt = it >> 5, kt = it & 31; d.W = P.w_mlp_out; d.Wt = (u16*)(P.ws + WS_W2T); d.N = DM; d.K = DFF; d.k0 = kt * 256; d.n0 = nt * 32; d.drow0 = nt * 32; return d;
}
template <int WHICH> __device__ __forceinline__ void wt_loop(const Params& P, u16* L, int lo, int hi, int rank, int count) {
    int it = lo + rank; f32x4v v[4]; WtDesc d{};
#define WT_DESC(i_) (WHICH == 0 ? wt_desc_prep(P, (i_)) : (WHICH == 1 ? wt_desc_w1(P, (i_)) : wt_desc_w2(P, (i_))))
    if (it < hi) { d = WT_DESC(it); wt_load(d, v); }
    for (; it < hi; it += count) {
        wt_to_lds(v, L);
        __syncthreads();
        WtDesc dn = d; const int itn = it + count;
        if (itn < hi) { dn = WT_DESC(itn); wt_load(dn, v); }
        wt_from_lds(d, L);
        __syncthreads();
        d = dn;
    }
#undef WT_DESC
}
__device__ void phase_prep(const Params& P, unsigned char* lds) {
    u16* L = (u16*)lds; const int tid = opaque_tid(), G = gridDim.x;
    unsigned char* ws = P.ws; unsigned char* dob = (unsigned char*)P.out;
    wt_loop<0>(P, L, 0, 3344 + 1536, blockIdx.x, G);
    for (int e = blockIdx.x * 512 + tid; e < 2048; e += G * 512) { const int pos = e >> 5, j = e & 31;
        double inv = 1.0; for (int q = 0; q < j; ++q) inv *= 0.74989420933245582730;
        const double rev = (double)pos * inv * 0.15915494309189533577; const float fr = (float)(rev - floor(rev));
        float* tab = (float*)(ws + WS_ROPE); tab[2 * e] = __builtin_amdgcn_cosf(fr); tab[2 * e + 1] = __builtin_amdgcn_sinf(fr); }
    { const int lane = tid & 63; u16* H = (u16*)(dob + DO_H);
      int row = blockIdx.x * 8 + (tid >> 6); f32x4v v[8];
      if (row < T_TOK) {
#pragma unroll
          for (int i = 0; i < 8; ++i) v[i] = __builtin_nontemporal_load((const f32x4v*)(P.x + (size_t)row * DM + (i * 64 + lane) * 4)); }
      for (; row < T_TOK; row += G * 8) {
          f32x4v c[8]; float s = 0.f;
#pragma unroll
          for (int i = 0; i < 8; ++i) { c[i] = v[i]; s += c[i][0] * c[i][0] + c[i][1] * c[i][1] + c[i][2] * c[i][2] + c[i][3] * c[i][3]; }
          const int rn = row + G * 8;
          if (rn < T_TOK) {
#pragma unroll
              for (int i = 0; i < 8; ++i) v[i] = __builtin_nontemporal_load((const f32x4v*)(P.x + (size_t)rn * DM + (i * 64 + lane) * 4)); }
#pragma unroll
          for (int o = 32; o; o >>= 1) s += __shfl_xor(s, o);
          const float rstd = __builtin_amdgcn_rsqf(s * (1.f / DM) + EPSN);
#pragma unroll
          for (int i = 0; i < 8; ++i) { const f32x4v g4 = *(const f32x4v*)(P.g_mix + (i * 64 + lane) * 4); const f32x4v y = c[i] * rstd * g4;
              u32x2v w; w.x = cvtpk2(y[0], y[1]); w.y = cvtpk2(y[2], y[3]); *(u32x2v*)(H + (size_t)row * DM + (i * 64 + lane) * 4) = w; } } }
}

__device__ void phase_dt(const Params& P, unsigned char* lds) {
    const int tid = opaque_tid(), w = tid >> 6, lane = tid & 63, quad = lane >> 4, l15 = lane & 15;
    const u16* H = (const u16*)((unsigned char*)P.out + DO_H); const u16* W = (const u16*)((unsigned char*)P.out + DO_WIN) + (size_t)13312 * DM;
    float* D = (float*)(P.ws + WS_DT); float* red = (float*)lds;
    for (int rb = blockIdx.x; rb < T_TOK / 64; rb += gridDim.x) {
        f32x4v acc[4][4];
#pragma unroll
        for (int i = 0; i < 4; ++i)
#pragma unroll
            for (int j = 0; j < 4; ++j) acc[i][j] = (f32x4v){0.f, 0.f, 0.f, 0.f};
        const u16* Hb = H + (size_t)(rb * 64 + l15) * DM + w * 256 + quad * 8; const u16* Wb = W + (size_t)l15 * DM + w * 256 + quad * 8;
#pragma unroll 1
        for (int half = 0; half < 2; ++half) {
            bf16x8v a[4][4], b[4][4];
#pragma unroll
            for (int ks = 0; ks < 4; ++ks)
#pragma unroll
                for (int i = 0; i < 4; ++i) { a[ks][i] = *(const bf16x8v*)(Hb + (size_t)(i * 16) * DM + (half * 4 + ks) * 32); b[ks][i] = *(const bf16x8v*)(Wb + (size_t)(i * 16) * DM + (half * 4 + ks) * 32); }
#pragma unroll
            for (int ks = 0; ks < 4; ++ks)
#pragma unroll
                for (int i = 0; i < 4; ++i)
#pragma unroll
                    for (int j = 0; j < 4; ++j) acc[i][j] = MFMA16(a[ks][i], b[ks][j], acc[i][j]);
        }
        __syncthreads();
#pragma unroll
        for (int i = 0; i < 4; ++i)
#pragma unroll
            for (int j = 0; j < 4; ++j)
#pragma unroll
                for (int e2 = 0; e2 < 4; ++e2) red[(w * 64 + i * 16 + quad * 4 + e2) * 64 + j * 16 + l15] = acc[i][j][e2];
        __syncthreads();
        for (int o = tid; o < 4096; o += 512) { float s2 = 0.f;
#pragma unroll
            for (int ww = 0; ww < 8; ++ww) s2 += red[ww * 4096 + o];
            D[(size_t)(rb * 64 + (o >> 6)) * 64 + (o & 63)] = s2; }
    }
    __syncthreads();
}
__device__ void phase_conv(const Params& P) {
    const int tid = opaque_tid(), ch0 = tid * 8;
    float wgt[5][8], bia[8];
#pragma unroll
    for (int j = 0; j < 5; ++j) { const f32x4v a = *(const f32x4v*)(P.conv_w + j * 4096 + ch0), b = *(const f32x4v*)(P.conv_w + j * 4096 + ch0 + 4);
#pragma unroll
        for (int e = 0; e < 4; ++e) { wgt[j][e] = a[e]; wgt[j][4 + e] = b[e]; } }
    { const f32x4v a = *(const f32x4v*)(P.conv_b + ch0), b = *(const f32x4v*)(P.conv_b + ch0 + 4);
#pragma unroll
      for (int e = 0; e < 4; ++e) { bia[e] = a[e]; bia[4 + e] = b[e]; } }
    const u16* RAW = (const u16*)(P.ws + WS_R0); u16* OUTP = (u16*)((unsigned char*)P.out + DO_XBC);
#define CONV_LOAD(it_, dst) do { const int t0_ = (it_) * 16, s0_ = t0_ & (SEQ - 1); _Pragma("unroll") for (int r = 0; r < 20; ++r) { const bool ok = (r >= 2 || s0_ != 0) && (r < 18 || s0_ + 16 != SEQ); \
        dst[r] = (u32x4v){0u, 0u, 0u, 0u}; if (ok) dst[r] = *(const u32x4v*)(RAW + (size_t)(t0_ + r - 2) * 4096 + ch0); } } while (0)
    u32x4v nrows[20];
    if ((int)blockIdx.x < 1024) CONV_LOAD(blockIdx.x, nrows);
    for (int it = blockIdx.x; it < 1024; it += gridDim.x) {
        const int t0 = it * 16;
        u32x4v rows[20];
#pragma unroll
        for (int r = 0; r < 20; ++r) rows[r] = nrows[r];
        { const int nit = it + gridDim.x; if (nit < 1024) CONV_LOAD(nit, nrows); }
        float win[5][8];
#pragma unroll
        for (int r = 0; r < 4; ++r) unpack_bf8(rows[r], win[r]);
#pragma unroll
        for (int tt = 0; tt < 16; ++tt) {
            unpack_bf8(rows[tt + 4], win[4]);
            float o[8];
#pragma unroll
            for (int e = 0; e < 8; ++e) { float a = bia[e];
#pragma unroll
                for (int j = 0; j < 5; ++j) a = fmaf(wgt[j][e], win[j][e], a);
                o[e] = siluf_(a); }
            *(bf16x8v*)(OUTP + (size_t)(t0 + tt) * 4096 + ch0) = pack_bf8(o);
#pragma unroll
            for (int j = 0; j < 4; ++j)
#pragma unroll
                for (int e = 0; e < 8; ++e) win[j][e] = win[j + 1][e];
        }
    }
}
#undef CONV_LOAD
__device__ void phase_knorm_rope(const Params& P) {
    const int tid = opaque_tid(), l16 = tid & 15; const float* tab = (const float*)(P.ws + WS_ROPE);
    u16* K = (u16*)(P.ws + WS_K);
    const int NR = T_TOK * 4; const float* g = P.k_norm_g;
    int r = blockIdx.x * 32 + (tid >> 4); const int rstep = gridDim.x * 32; u32x4v curq = {0u, 0u, 0u, 0u};
    if (r < NR) curq = *(const u32x4v*)(K + (size_t)(r >> 2) * 512 + (r & 3) * 128 + l16 * 8);
    for (; r < NR; r += rstep) {
        const int token = r >> 2; u16* ptr = K + (size_t)token * 512 + (r & 3) * 128;
        float v[8]; unpack_bf8(curq, v);
        { const int rn = r + rstep; if (rn < NR) curq = *(const u32x4v*)(K + (size_t)(rn >> 2) * 512 + (rn & 3) * 128 + l16 * 8); }
        float s = 0.f;
#pragma unroll
        for (int e = 0; e < 8; ++e) s += v[e] * v[e];
        s += __shfl_xor(s, 1); s += __shfl_xor(s, 2); s += __shfl_xor(s, 4); s += __shfl_xor(s, 8);
        const float rstd = __builtin_amdgcn_rsqf(s * (1.f / 128.f) + EPSN);
        const f32x4v g0 = *(const f32x4v*)(g + l16 * 8), g1 = *(const f32x4v*)(g + l16 * 8 + 4);
#pragma unroll
        for (int e = 0; e < 4; ++e) { v[e] *= rstd * g0[e]; v[4 + e] *= rstd * g1[e]; }
        const int sp = token & (SEQ - 1); const int pos = (l16 < 8) ? (sp >> 6) : (sp & 63); const int j0 = (l16 & 7) * 4;
        const f32x4v c0 = *(const f32x4v*)(tab + (pos * 32 + j0) * 2), c1 = *(const f32x4v*)(tab + (pos * 32 + j0) * 2 + 4);
        float o[8];
        o[0] = v[0] * c0[0] - v[1] * c0[1]; o[1] = v[0] * c0[1] + v[1] * c0[0];
        o[2] = v[2] * c0[2] - v[3] * c0[3]; o[3] = v[2] * c0[3] + v[3] * c0[2];
        o[4] = v[4] * c1[0] - v[5] * c1[1]; o[5] = v[4] * c1[1] + v[5] * c1[0];
        o[6] = v[6] * c1[2] - v[7] * c1[3]; o[7] = v[6] * c1[3] + v[7] * c1[2];
        *(bf16x8v*)(ptr + l16 * 8) = pack_bf8(o);
    }
}

constexpr int PX = 528, PB = 272;
__device__ __forceinline__ void ssd_dt_load(const Params& P, int t0, int g, float& r0v, float& r1v) {
    const int tid = opaque_tid(), w = tid >> 6, lane = tid & 63, hh = w & 3, dir = w >> 2, h = g * 4 + hh;
    const float* DT = (const float*)(P.ws + WS_DT);
    const int r0 = 2 * lane, l0 = dir ? 127 - r0 : r0, l1 = dir ? 126 - r0 : r0 + 1;
    r0v = DT[(size_t)(t0 + l0) * 64 + dir * 32 + h]; r1v = DT[(size_t)(t0 + l1) * 64 + dir * 32 + h];
}
__device__ __forceinline__ float ssd_tables(const Params& P, int g, float r0v, float r1v, float* acum, float* dtab) {
    const int tid = opaque_tid(), w = tid >> 6, lane = tid & 63, hh = w & 3, dir = w >> 2, h = g * 4 + hh;
    const float bias = dir ? P.dt_bias_b[h] : P.dt_bias_f[h];
    const float A = -__expf(dir ? P.a_log_b[h] : P.a_log_f[h]);
    const int r0 = 2 * lane, l0 = dir ? 127 - r0 : r0, l1 = dir ? 126 - r0 : r0 + 1;
    const float x0 = r0v + bias, x1 = r1v + bias;
    const float d0 = x0 > 20.f ? x0 : log1pf(__expf(x0)), d1 = x1 > 20.f ? x1 : log1pf(__expf(x1));
    const float a0 = A * d0, a1 = A * d1, s1 = a0 + a1; float v = s1;
#pragma unroll
    for (int d = 1; d < 64; d <<= 1) { const float t = __shfl_up(v, d); if (lane >= d) v += t; }
    const float ex = v - s1;
    acum[w * 128 + l0] = ex + a0; acum[w * 128 + l1] = ex + s1; dtab[w * 128 + l0] = d0; dtab[w * 128 + l1] = d1;
    return __shfl(v, 63);
}
__device__ __forceinline__ void ssd_stage_xb(const u16* XBC, int t0, int g, unsigned char* Ximg, unsigned char* Bimg) {
    const int tid = opaque_tid();
#pragma unroll
    for (int i = 0; i < 8; ++i) { const int q = tid + 512 * i, row = q >> 5, ch = q & 31; *(u32x4v*)(Ximg + row * PX + ch * 16) = *(const u32x4v*)(XBC + (size_t)(t0 + row) * 4096 + g * 256 + ch * 8); }
#pragma unroll
    for (int i = 0; i < 4; ++i) { const int q = tid + 512 * i, row = q >> 4, ch = q & 15; *(u32x4v*)(Bimg + row * PB + ch * 16) = *(const u32x4v*)(XBC + (size_t)(t0 + row) * 4096 + 2048 + g * 128 + ch * 8); }
}
__device__ __forceinline__ void ssd_xb_load(const u16* XBC, int t0, int g, u32x4v (&xr)[8], u32x4v (&br)[4]) {
    const int tid = opaque_tid();
#pragma unroll
    for (int i = 0; i < 8; ++i) { const int q = tid + 512 * i, row = q >> 5, ch = q & 31; xr[i] = *(const u32x4v*)(XBC + (size_t)(t0 + row) * 4096 + g * 256 + ch * 8); }
#pragma unroll
    for (int i = 0; i < 4; ++i) { const int q = tid + 512 * i, row = q >> 4, ch = q & 15; br[i] = *(const u32x4v*)(XBC + (size_t)(t0 + row) * 4096 + 2048 + g * 128 + ch * 8); }
}
__device__ __forceinline__ void ssd_xb_store(const u32x4v (&xr)[8], const u32x4v (&br)[4], unsigned char* Ximg, unsigned char* Bimg) {
    const int tid = opaque_tid();
#pragma unroll
    for (int i = 0; i < 8; ++i) { const int q = tid + 512 * i, row = q >> 5, ch = q & 31; *(u32x4v*)(Ximg + row * PX + ch * 16) = xr[i]; }
#pragma unroll
    for (int i = 0; i < 4; ++i) { const int q = tid + 512 * i, row = q >> 4, ch = q & 15; *(u32x4v*)(Bimg + row * PB + ch * 16) = br[i]; }
}
__device__ void ssd_chunk_states_all(const Params& P, unsigned char* lds) {
    const u16* XBC0 = (const u16*)((unsigned char*)P.out + DO_XBC);
    u32x4v xr[8], br[4]; float dr0 = 0.f, dr1 = 0.f;
    int item = blockIdx.x;
    if (item < 1024) { const int b0 = item >> 8, c0 = (item >> 3) & 31, g0 = item & 7, tt = b0 * SEQ + c0 * 128; ssd_dt_load(P, tt, g0, dr0, dr1); ssd_xb_load(XBC0, tt, g0, xr, br); }
    for (; item < 1024; item += gridDim.x) {
    const int tid = opaque_tid(), w = tid >> 6, lane = tid & 63, hh = w & 3, dir = w >> 2, quad = lane >> 4, l15 = lane & 15;
    const int b = item >> 8, c = (item >> 3) & 31, g = item & 7, t0 = b * SEQ + c * 128, h = g * 4 + hh;
    unsigned char* Ximg = lds; unsigned char* Bimg = lds + 128 * PX;
    float* acum = (float*)(lds + 128 * PX + 128 * PB); float* dtab = acum + 1024; float* wtab = dtab + 1024; float* tot = wtab + 1024;
    __syncthreads();
    ssd_xb_store(xr, br, Ximg, Bimg);
    const float total = ssd_tables(P, g, dr0, dr1, acum, dtab);
    if (lane == 0) { tot[w] = total; ((float*)(P.ws + WS_CDEC))[((b * 32 + c) * 32 + h) * 2 + dir] = __expf(total); }
    __syncthreads();
    for (int i = tid; i < 1024; i += 512) wtab[i] = dtab[i] * __expf(tot[i >> 7] - acum[i]);
    { const int nitem = item + gridDim.x;
      if (nitem < 1024) { const int nb = nitem >> 8, nc = (nitem >> 3) & 31, ng = nitem & 7, nt0 = nb * SEQ + nc * 128; ssd_dt_load(P, nt0, ng, dr0, dr1); ssd_xb_load(XBC0, nt0, ng, xr, br); } }
    __syncthreads();
    f32x4v acc[8][4];
#pragma unroll
    for (int nb = 0; nb < 8; ++nb)
#pragma unroll
        for (int pb = 0; pb < 4; ++pb) acc[nb][pb] = (f32x4v){0.f, 0.f, 0.f, 0.f};
    const int trow = quad * 8 + (l15 >> 2), tcol = (l15 & 3) * 4;
#pragma unroll 1
    for (int ks = 0; ks < 4; ++ks) {
        const f32x4v w0 = *(const f32x4v*)(wtab + w * 128 + ks * 32 + quad * 8), w1 = *(const f32x4v*)(wtab + w * 128 + ks * 32 + quad * 8 + 4);
        bf16x8v bfr[4];
#pragma unroll
        for (int pb = 0; pb < 4; ++pb) {
            const unsigned char* px = Ximg + (ks * 32 + trow) * PX + (hh * 64 + pb * 16 + tcol) * 2;
            const s16x4v lo = tr_read16(px), hi = tr_read16(px + 4 * PX);
            float m[8];
#pragma unroll
            for (int j = 0; j < 4; ++j) { m[j] = bf2f((u16)lo[j]) * w0[j]; m[4 + j] = bf2f((u16)hi[j]) * w1[j]; }
            bfr[pb] = pack_bf8(m); }
#pragma unroll
        for (int nb = 0; nb < 8; ++nb) {
            const unsigned char* pbm = Bimg + (ks * 32 + trow) * PB + (nb * 16 + tcol) * 2;
            const s16x4v lo = tr_read16(pbm), hi = tr_read16(pbm + 4 * PB);
            const bf16x8v afr = {lo[0], lo[1], lo[2], lo[3], hi[0], hi[1], hi[2], hi[3]};
#pragma unroll
            for (int pb = 0; pb < 4; ++pb) acc[nb][pb] = MFMA16(afr, bfr[pb], acc[nb][pb]); }
    }
    u16* ST = (u16*)(P.ws + WS_R0) + ((((size_t)(b * 32 + c) * 32 + h) * 2 + dir) * 64) * 128;
#pragma unroll
    for (int nb = 0; nb < 8; ++nb)
#pragma unroll
        for (int pb = 0; pb < 4; ++pb) { u32x2v o; o.x = cvtpk2(acc[nb][pb][0], acc[nb][pb][1]); o.y = cvtpk2(acc[nb][pb][2], acc[nb][pb][3]);
            *(u32x2v*)(ST + (pb * 16 + l15) * 128 + nb * 16 + quad * 4) = o; }
    }
}
template <bool DUMP = false> __device__ void phase_scan(const Params& P) {
    u16* ST = (u16*)(P.ws + WS_R0); u16* DMP = (u16*)(P.ws + WS_DUMP); const float* CD = (const float*)(P.ws + WS_CDEC);
    for (int v = blockIdx.x * 512 + opaque_tid(); v < 262144; v += gridDim.x * 512) {
        const int n8 = v & 15, p = (v >> 4) & 63, dir = (v >> 10) & 1, h = (v >> 11) & 31, b = v >> 16;
        float st[8];
#pragma unroll
        for (int e = 0; e < 8; ++e) st[e] = 0.f;
#pragma unroll 1
        for (int i0 = 0; i0 < 32; i0 += 8) {
            u32x4v raw[8]; float dec[8]; size_t idx[8];
#pragma unroll
            for (int k = 0; k < 8; ++k) { const int i = i0 + k, c = dir ? 31 - i : i;
                idx[k] = ((((size_t)(b * 32 + c) * 32 + h) * 2 + dir) * 64 + p) * 128 + n8 * 8;
                raw[k] = *(const u32x4v*)(ST + idx[k]); dec[k] = CD[((b * 32 + c) * 32 + h) * 2 + dir]; }
#pragma unroll
            for (int k = 0; k < 8; ++k) { float f[8]; unpack_bf8(raw[k], f);
                if (DUMP) *(bf16x8v*)(DMP + (idx[k] & 0xfffff)) = pack_bf8(st); else *(bf16x8v*)(ST + idx[k]) = pack_bf8(st);
#pragma unroll
                for (int e = 0; e < 8; ++e) st[e] = fmaf(st[e], dec[k], f[e]); }
        }
    }
}
template <bool DUMP = false> __device__ void ssd_output(const Params& P, unsigned char* lds, int item) {
    const int tid = opaque_tid(), w = tid >> 6, lane = tid & 63, quad = lane >> 4, l15 = lane & 15;
    const int b = item >> 8, c = (item >> 3) & 31, g = item & 7, t0 = b * SEQ + c * 128;
    const u16* XBC = (const u16*)((unsigned char*)P.out + DO_XBC);
    unsigned char* Ximg = lds; unsigned char* Bimg = lds + 128 * PX; unsigned char* Simg = Bimg + 128 * PB;
    float* acum = (float*)(Simg + 128 * PB); float* dtab = acum + 1024;
    const u16* STb = (const u16*)(P.ws + WS_R0);
    const u16* Z = (const u16*)(P.ws + WS_Z); u16* ZO = DUMP ? (u16*)(P.ws + WS_DUMP) - (size_t)t0 * 2048 : (u16*)(P.ws + WS_Z);
    const int l = 16 * w + l15;
    bf16x8v cfr[4];
#pragma unroll
    for (int ks = 0; ks < 4; ++ks) cfr[ks] = *(const bf16x8v*)(XBC + (size_t)(t0 + l) * 4096 + 3072 + g * 128 + ks * 32 + quad * 8);
    __syncthreads();
    float dr0, dr1; ssd_dt_load(P, t0, g, dr0, dr1);
    ssd_stage_xb(XBC, t0, g, Ximg, Bimg);
    (void)ssd_tables(P, g, dr0, dr1, acum, dtab);
    __syncthreads();
    const u16* STb0 = STb; (void)STb0;
    u32x4v sreg[8];
#define SSD_SLOAD(hp_) do { _Pragma("unroll") for (int i = 0; i < 8; ++i) { const int q = tid + 512 * i, hl = q >> 11, d = (q >> 10) & 1, row = (q >> 4) & 63, ch = q & 15; \
        sreg[i] = *(const u32x4v*)(STb + ((((size_t)(b * 32 + c) * 32 + g * 4 + (hp_) * 2 + hl) * 2 + d) * 64 + row) * 128 + ch * 8); } } while (0)
#define SSD_SWRITE() do { _Pragma("unroll") for (int i = 0; i < 8; ++i) { const int q = tid + 512 * i, img = q >> 10, row = (q >> 4) & 63, ch = q & 15; \
        *(u32x4v*)(S2 + (img * 64 + row) * PB + ch * 16) = sreg[i]; } } while (0)
    SSD_SLOAD(0);
    f32x4v gt[8];
#pragma unroll
    for (int sb = 0; sb < 8; ++sb) { gt[sb] = (f32x4v){0.f, 0.f, 0.f, 0.f};
#pragma unroll
        for (int ks = 0; ks < 4; ++ks) { const bf16x8v a = *(const bf16x8v*)(Bimg + (sb * 16 + l15) * PB + (ks * 32 + quad * 8) * 2); gt[sb] = MFMA16(a, cfr[ks], gt[sb]); } }
    float ssq = 0.f;
    const int wh = w >> 1;
    unsigned char* S2 = Bimg;
#pragma unroll 1
    for (int hp = 0; hp < 2; ++hp) {
        __syncthreads();
        SSD_SWRITE();
        __syncthreads();
        if (hp == 0) SSD_SLOAD(1);
#pragma unroll 1
    for (int hl = 0; hl < 2; ++hl) {
        const int hh = hp * 2 + hl, h = g * 4 + hh;
        const size_t zoff = (size_t)(t0 + l) * 2048 + g * 256 + hh * 64 + quad * 16;
        const u32x4v zq0 = *(const u32x4v*)(Z + zoff), zq1 = *(const u32x4v*)(Z + zoff + 8);
        f32x4v y[4];
#pragma unroll
        for (int pb = 0; pb < 4; ++pb) y[pb] = (f32x4v){0.f, 0.f, 0.f, 0.f};
#pragma unroll
        for (int dir = 0; dir < 2; ++dir) {
            const float* ac = acum + (dir * 4 + hh) * 128; const float* dtb = dtab + (dir * 4 + hh) * 128;
            const float acl = ac[l];
#pragma unroll 1
            for (int kk = 0; kk < 4; ++kk) {
                const bool active = dir == 0 ? (kk <= wh) : (kk >= wh);
                if (!active) continue;
                float m[8];
#pragma unroll
                for (int half = 0; half < 2; ++half) { const int s0 = kk * 32 + half * 16 + quad * 4;
                    const f32x4v as = *(const f32x4v*)(ac + s0), ds = *(const f32x4v*)(dtb + s0);
                    const f32x4v gv = half == 0 ? (kk == 0 ? gt[0] : kk == 1 ? gt[2] : kk == 2 ? gt[4] : gt[6]) : (kk == 0 ? gt[1] : kk == 1 ? gt[3] : kk == 2 ? gt[5] : gt[7]);
#pragma unroll
                    for (int j = 0; j < 4; ++j) { const int s = s0 + j; const bool ok = dir == 0 ? (s <= l) : (s >= l);
                        const float e = __expf(fminf(acl - as[j], 0.f));
                        m[half * 4 + j] = ok ? gv[j] * e * ds[j] : 0.f; } }
                const bf16x8v afr = pack_bf8(m);
#pragma unroll
                for (int pb = 0; pb < 4; ++pb) {
                    const unsigned char* px = Ximg + (kk * 32 + quad * 4 + (l15 >> 2)) * PX + (hh * 64 + (l15 & 3) * 16 + pb * 4) * 2;
                    const s16x4v lo = tr_read16(px), hi = tr_read16(px + 16 * PX);
                    const bf16x8v xfr = {lo[0], lo[1], lo[2], lo[3], hi[0], hi[1], hi[2], hi[3]};
                    y[pb] = MFMA16(xfr, afr, y[pb]); }
            }
            const float el = __expf(acl);
#pragma unroll
            for (int ks = 0; ks < 4; ++ks) { float cf[8]; unpack_bf8(*reinterpret_cast<const u32x4v*>(&cfr[ks]), cf);
#pragma unroll
                for (int e = 0; e < 8; ++e) cf[e] *= el;
                const bf16x8v a = pack_bf8(cf);
#pragma unroll
                for (int pb = 0; pb < 4; ++pb) { const bf16x8v sf = *(const bf16x8v*)(S2 + ((hl * 2 + dir) * 64 + (l15 >> 2) * 16 + pb * 4 + (l15 & 3)) * PB + (ks * 32 + quad * 8) * 2); y[pb] = MFMA16(sf, a, y[pb]); } }
        }
        const float Dh = P.d_skip[h];
        { float xv[16], zv[16], o[16];
          unpack_bf8(*(const u32x4v*)(Ximg + l * PX + (hh * 64 + quad * 16) * 2), xv); unpack_bf8(*(const u32x4v*)(Ximg + l * PX + (hh * 64 + quad * 16 + 8) * 2), xv + 8);
          unpack_bf8(zq0, zv); unpack_bf8(zq1, zv + 8);
#pragma unroll
          for (int pb = 0; pb < 4; ++pb)
#pragma unroll
              for (int j = 0; j < 4; ++j) { const int c = pb * 4 + j; const float yv = (y[pb][j] + Dh * xv[c]) * siluf_(zv[c]); ssq += yv * yv; o[c] = yv; }
          *(bf16x8v*)(ZO + zoff) = pack_bf8(o); *(bf16x8v*)(ZO + zoff + 8) = pack_bf8(o + 8); }
    }
    }
#undef SSD_SLOAD
#undef SSD_SWRITE
    ssq += __shfl_xor(ssq, 16); ssq += __shfl_xor(ssq, 32);
    const float rstd = __builtin_amdgcn_rsqf(ssq * (1.f / 256.f) + EPSN);
    { u32x4v zq[4][2];
#pragma unroll
      for (int hh = 0; hh < 4; ++hh) { const size_t zoff = (size_t)(t0 + l) * 2048 + g * 256 + hh * 64 + quad * 16; zq[hh][0] = *(const u32x4v*)(ZO + zoff); zq[hh][1] = *(const u32x4v*)(ZO + zoff + 8); }
#pragma unroll
      for (int hh = 0; hh < 4; ++hh) { const size_t zoff = (size_t)(t0 + l) * 2048 + g * 256 + hh * 64 + quad * 16; const float* ngp = P.ssm_norm_g + g * 256 + hh * 64 + quad * 16;
        float v[16], o[16]; unpack_bf8(zq[hh][0], v); unpack_bf8(zq[hh][1], v + 8);
#pragma unroll
        for (int q4 = 0; q4 < 4; ++q4) { const f32x4v ng = *(const f32x4v*)(ngp + q4 * 4);
#pragma unroll
            for (int j = 0; j < 4; ++j) o[q4 * 4 + j] = v[q4 * 4 + j] * rstd * ng[j]; }
        *(bf16x8v*)(ZO + zoff) = pack_bf8(o); *(bf16x8v*)(ZO + zoff + 8) = pack_bf8(o + 8); } }
}
#ifndef DUPMASK
#define DUPMASK 0
#endif
__global__ void __launch_bounds__(512, 2) fwd_megakernel(Params P) {
    extern __shared__ __attribute__((aligned(16))) unsigned char lds[];
    cg::grid_group grid = cg::this_grid();
    const int G = gridDim.x, bid = blockIdx.x, tid = opaque_tid();
    unsigned char* ws = P.ws; unsigned char* dob = (unsigned char*)P.out;
    PG8_LAS unsigned char* glds = (PG8_LAS unsigned char*)lds;

    unsigned* barw = (unsigned*)(ws + WS_BAR);
    volatile LAS unsigned* bst = (volatile LAS unsigned*)(glds + LDS_BYTES - 16); if (tid < 4) bst[tid] = 0u;
    __syncthreads();
    const XcdBarrier xbar = xcd_barrier_post(barw, bst);
    const bool panel_ok = (G == 256); int mypm = 0; { pg8::StaticOrder S0; S0.init(T_TOK, DM, G, bid); pg8::Unit u0; if (S0.next(0, u0)) mypm = u0.pm; }
    unsigned* pcnt = (unsigned*)(ws + WS_PCNT);
    if (P.seq < 0) grid.sync();
    if (DUPMASK & (4 | 32)) { phase_prep(P, lds); __syncthreads(); }
    phase_prep(P, lds);
    xcd_barrier(xbar);
    phase_dt(P, lds);
    const int late = (bid >> 3) & 1, hrank = ((bid >> 4) << 3) | (bid & 7);
    const int hrem = (G & 15) - 8 * late, hcount = (G >> 4) * 8 + (hrem < 0 ? 0 : (hrem > 8 ? 8 : hrem));
    if (late) wt_loop<1>(P, (u16*)lds, 0, 1024, hrank, hcount);
    { pg8::Gemm g{(const u16*)(dob + DO_H), (const u16*)(dob + DO_WIN), T_TOK, NPROJ_PAD, DM}; pg8::StaticOrder S; S.init(T_TOK, NPROJ_PAD, G, bid);
      pg8::EpiProj E{ws}; if (DUPMASK & 1) pg8::gemm_phase<pg8::EpiProj, pg8::StaticOrder, true, true>(glds, g, S, E);
      pg8::gemm_phase<pg8::EpiProj, pg8::StaticOrder, true, true>(glds, g, S, E); }
    if (!late) wt_loop<1>(P, (u16*)lds, 1024, 2048, hrank, hcount);
    xcd_barrier(xbar);
    if (DUPMASK & (4 | 64)) phase_conv(P);
    phase_conv(P);
    phase_knorm_rope(P);
    xcd_barrier(xbar);
    for (int it = bid; it < 1024; it += G) {
        const int round = it >> 8, blk = it & 255, xcd = blk & 7, slot = blk >> 3, kvh = xcd & 3, sub = (xcd >> 2) * 32 + slot, hq = kvh * 4 + (sub >> 4), qb = sub & 15;
        const size_t tokq = (size_t)round * SEQ + qb * 256;
        const long q0 = (long)tokq * 2048 + hq * 128, k0 = (long)round * SEQ * 512 + kvh * 128;
        att::bf16* Qb = P.aq + q0; const att::bf16* Kh = P.ak + k0; const att::bf16* Vh = P.av + k0;
        __syncthreads();
        if (DUPMASK & 2) { att::attn_dense_body<att::bf16>(Qb, Kh, Vh, (att::bf16*)(ws + WS_DUMP) + (blk & 7) * 128, P.seq, (char*)lds, P.q_norm_g, (const float*)(ws + WS_ROPE), qb * 256); __syncthreads(); }
        att::attn_dense_body<att::bf16>(Qb, Kh, Vh, Qb, P.seq, (char*)lds, P.q_norm_g, (const float*)(ws + WS_ROPE), qb * 256);
    }
    __syncthreads();
    ssd_chunk_states_all(P, lds);
    xcd_barrier(xbar);
    if (DUPMASK & (8 | 128)) phase_scan<true>(P);
    phase_scan<false>(P);
    xcd_barrier(xbar);
    if (DUPMASK & 8) for (int it = bid; it < 1024; it += G) ssd_output<true>(P, lds, it);
    for (int it = bid; it < 1024; it += G) ssd_output<false>(P, lds, it);
    xcd_barrier(xbar);
    { pg8::StaticOrder S; S.init(T_TOK, DM, G, bid);
      pg8::Gemm g{(const u16*)(ws + WS_Z), (const u16*)(ws + WS_WSSM), T_TOK, DM, DM, (const u16*)(ws + WS_Q), (const u16*)(ws + WS_WATT)};
      pg8::EpiGate2 E{ws + WS_GA, ws + WS_GB, (u16*)(ws + WS_MG)};
      pg8::gemm_phase<pg8::EpiGate2, pg8::StaticOrder, true, true, true>(glds, g, S, E); }
    if (panel_ok) panel_sync(pcnt + (size_t)mypm * 64, 4u); else xcd_barrier(xbar);
    { pg8::Gemm g{(const u16*)(ws + WS_MG), (const u16*)(ws + WS_WOUT), T_TOK, DM, DM}; pg8::StaticOrder S; S.init(T_TOK, DM, G, bid);
      pg8::EpiResB<0> E{P.x, (u16*)(ws + WS_R0), (float*)(ws + WS_SSQ1)}; pg8::gemm_phase<pg8::EpiResB<0>, pg8::StaticOrder, true, true>(glds, g, S, E); }
    xcd_barrier(xbar);
    if (late) wt_loop<2>(P, (u16*)lds, 0, 1024, hrank, hcount);
    { pg8::Gemm g{(const u16*)(ws + WS_R0), (const u16*)(ws + WS_W1T), T_TOK, DFF, DM}; pg8::StaticOrder S; S.init(T_TOK, DFF, G, bid);
      pg8::EpiMlpIn E{(u16*)(ws + WS_U), (const float*)(ws + WS_SSQ1)}; if (DUPMASK & (1 | 256)) pg8::gemm_phase<pg8::EpiMlpIn, pg8::StaticOrder, true, true>(glds, g, S, E); pg8::gemm_phase<pg8::EpiMlpIn, pg8::StaticOrder, true, true>(glds, g, S, E); }
    if (!late) wt_loop<2>(P, (u16*)lds, 1024, 2048, hrank, hcount);
    xcd_barrier(xbar);
    { pg8::Gemm g{(const u16*)(ws + WS_U), (const u16*)(ws + WS_W2T), T_TOK, DM, DFF}; pg8::StaticOrder S; S.init(T_TOK, DM, G, bid);
      pg8::EpiResB<1> E{nullptr, (u16*)(ws + WS_R0), (float*)(ws + WS_SSQ2)}; pg8::gemm_phase<pg8::EpiResB<1>, pg8::StaticOrder, true, true>(glds, g, S, E); }
    if (panel_ok) panel_sync(pcnt + (size_t)(64 + mypm) * 64, 4u); else xcd_barrier(xbar);
    { const int lane = tid & 63; const float* SS = (const float*)(ws + WS_SSQ2); const u16* X2 = (const u16*)(ws + WS_R0);
      const int row_end = panel_ok ? mypm * 256 + (bid >> 6) * 64 + 64 : T_TOK, row_step = panel_ok ? 8 : G * 8;
      int row = panel_ok ? mypm * 256 + (bid >> 6) * 64 + (tid >> 6) : bid * 8 + (tid >> 6); u32x4v nq[4]; float ns = 0.f;
      if (row < row_end) { ns = SS[(size_t)row * 32 + (lane & 31)];
#pragma unroll
          for (int i = 0; i < 4; ++i) nq[i] = *(const u32x4v*)(X2 + (size_t)row * DM + (i * 64 + lane) * 8); }
      for (; row < row_end; row += row_step) {
          u32x4v xq[4]; float s = ns;
#pragma unroll
          for (int i = 0; i < 4; ++i) xq[i] = nq[i];
          { const int rn = row + row_step; if (rn < row_end) { ns = SS[(size_t)rn * 32 + (lane & 31)];
#pragma unroll
              for (int i = 0; i < 4; ++i) nq[i] = *(const u32x4v*)(X2 + (size_t)rn * DM + (i * 64 + lane) * 8); } }
#pragma unroll
          for (int o = 16; o; o >>= 1) s += __shfl_xor(s, o);
          const float rstd = __builtin_amdgcn_rsqf(s * (1.f / DM) + EPSN);
          float* xr = P.out + (size_t)row * DM;
#pragma unroll
          for (int i = 0; i < 4; ++i) { const int cidx = (i * 64 + lane) * 8; float v[8]; unpack_bf8(xq[i], v);
              const f32x4v g0 = *(const f32x4v*)(P.g_final + cidx), g1 = *(const f32x4v*)(P.g_final + cidx + 4);
              f32x4v o0, o1;
#pragma unroll
              for (int j = 0; j < 4; ++j) { o0[j] = v[j] * rstd * g0[j]; o1[j] = v[4 + j] * rstd * g1[j]; }
              *(f32x4v*)(xr + cidx) = o0; *(f32x4v*)(xr + cidx + 4) = o1; } } }
}

extern "C" void kernel_launch(void* const* d_in, const int* in_sizes, int n_in, void* d_out, int out_size, void* d_ws, size_t ws_size, hipStream_t stream) {
    static int grid_blocks = 0;
    if (grid_blocks == 0) {
        if (n_in != 20 || in_sizes[0] != T_TOK * DM || out_size != T_TOK * DM || ws_size < WS_END) {
            fprintf(stderr, "kernel_launch: shape mismatch n_in %d in0 %d out %d ws %zu (need %zu)\n", n_in, n_in > 0 ? in_sizes[0] : -1, out_size, ws_size, (size_t)WS_END); grid_blocks = -1; return; }
        int dev = 0, cus = 0, per_cu = 0;
        (void)hipGetDevice(&dev); (void)hipDeviceGetAttribute(&cus, hipDeviceAttributeMultiprocessorCount, dev);
        if (hipFuncSetAttribute((const void*)fwd_megakernel, hipFuncAttributeMaxDynamicSharedMemorySize, LDS_BYTES) != hipSuccess) { fprintf(stderr, "kernel_launch: hipFuncSetAttribute failed\n"); grid_blocks = -1; return; }
        if (hipOccupancyMaxActiveBlocksPerMultiprocessor(&per_cu, (const void*)fwd_megakernel, 512, LDS_BYTES) != hipSuccess || per_cu < 1) { fprintf(stderr, "kernel_launch: occupancy query says %d\n", per_cu); per_cu = 1; }
        (void)hipGetLastError();
        grid_blocks = cus * 1;
    }
    if (grid_blocks < 0) return;
    Params p{};
    p.x = (const float*)d_in[0]; p.g_mix = (const float*)d_in[1]; p.w_in = (const float*)d_in[2]; p.conv_w = (const float*)d_in[3]; p.conv_b = (const float*)d_in[4];
    p.dt_bias_f = (const float*)d_in[5]; p.dt_bias_b = (const float*)d_in[6]; p.a_log_f = (const float*)d_in[7]; p.a_log_b = (const float*)d_in[8]; p.d_skip = (const float*)d_in[9];
    p.ssm_norm_g = (const float*)d_in[10]; p.q_norm_g = (const float*)d_in[11]; p.k_norm_g = (const float*)d_in[12]; p.w_ssm_up = (const float*)d_in[13]; p.w_attn_up = (const float*)d_in[14];
    p.w_out = (const float*)d_in[15]; p.g_mlp = (const float*)d_in[16]; p.w_mlp_in = (const float*)d_in[17]; p.w_mlp_out = (const float*)d_in[18]; p.g_final = (const float*)d_in[19];
    p.out = (float*)d_out; p.ws = (unsigned char*)d_ws; p.seq = SEQ; p.pad = 0; p.aq = (__hip_bfloat16*)((unsigned char*)d_ws + WS_Q); p.ak = (const __hip_bfloat16*)((unsigned char*)d_ws + WS_K); p.av = (const __hip_bfloat16*)((unsigned char*)d_ws + WS_V);
    if (hipMemsetAsync((unsigned char*)d_ws + WS_BAR, 0, BAR_ZERO_BYTES, stream) != hipSuccess) { fprintf(stderr, "kernel_launch: memset of the barrier words failed\n"); return; }
    void* args[] = {&p};
    hipError_t e = hipLaunchCooperativeKernel((const void*)fwd_megakernel, dim3(grid_blocks), dim3(512), args, LDS_BYTES, stream);
    if (e != hipSuccess) fprintf(stderr, "kernel_launch: cooperative launch failed: %s (grid %d)\n", hipGetErrorString(e), grid_blocks);
}
```

```cpp
#include <hip/hip_runtime.h>
#include <hip/hip_bf16.h>
#include <hip/hip_cooperative_groups.h>
#include <cstdio>
#include <cstdint>
namespace cg = cooperative_groups;

typedef unsigned short u16;
typedef short s16x4v __attribute__((ext_vector_type(4)));
typedef float f32x2v __attribute__((ext_vector_type(2)));
typedef unsigned u32x2v __attribute__((ext_vector_type(2)));
#define LAS3 __attribute__((address_space(3)))

constexpr int T_TOK = 16384, SEQ = 4096, DM = 2048, DFF = 8192, NIN = 13376;
constexpr int NPROJ_PAD = 13312;
constexpr float EPSN = 1e-6f;
constexpr size_t MiB = 1024 * 1024;
constexpr size_t WS_R0 = 0;
constexpr size_t WS_Z = 128 * MiB;
constexpr size_t WS_Q = 192 * MiB;
constexpr size_t WS_K = 256 * MiB;
constexpr size_t WS_V = 272 * MiB;
constexpr size_t WS_GA = 288 * MiB;
constexpr size_t WS_GB = 320 * MiB;
constexpr size_t WS_MG = 352 * MiB;
constexpr size_t WS_U = 128 * MiB;
constexpr size_t WS_WSSM = 416 * MiB;
constexpr size_t WS_WATT = 424 * MiB;
constexpr size_t WS_WOUT = 432 * MiB;
constexpr size_t WS_W2T = 440 * MiB;
constexpr size_t WS_DT = 472 * MiB;
constexpr size_t WS_ROPE = 476 * MiB;
constexpr size_t WS_CDEC = WS_ROPE + 64 * 1024;
constexpr size_t WS_BAR = WS_ROPE + 128 * 1024;
constexpr size_t WS_SSQ1 = 477 * MiB;
constexpr size_t WS_SSQ2 = WS_SSQ1;
constexpr size_t WS_W1T = 479 * MiB;
constexpr size_t WS_END = 511 * MiB;
constexpr size_t WS_DUMP = WS_ROPE + 256 * 1024;
constexpr size_t DO_H = 0, DO_WIN = 64 * MiB, DO_XBC = 0, DO_X1B = 0, DO_W1T = 64 * MiB;

constexpr int LDS_BYTES = 148 * 1024;

struct Params {
    const float* x; const float* g_mix; const float* w_in; const float* conv_w; const float* conv_b;
    const float* dt_bias_f; const float* dt_bias_b; const float* a_log_f; const float* a_log_b; const float* d_skip;
    const float* ssm_norm_g; const float* q_norm_g; const float* k_norm_g; const float* w_ssm_up; const float* w_attn_up;
    const float* w_out; const float* g_mlp; const float* w_mlp_in; const float* w_mlp_out; const float* g_final;
    float* out; unsigned char* ws; __hip_bfloat16* aq; const __hip_bfloat16* ak; const __hip_bfloat16* av; int seq; int pad;
};

__device__ __forceinline__ float bf2f(u16 v) { return __uint_as_float(((unsigned)v) << 16); }
__device__ __forceinline__ unsigned cvtpk2(float lo, float hi) { unsigned r; asm volatile("v_cvt_pk_bf16_f32 %0, %1, %2" : "=v"(r) : "v"(lo), "v"(hi)); return r; }
__device__ __forceinline__ u16 f2bf(float x) { return (u16)(cvtpk2(x, 0.f) & 0xffffu); }
__device__ __forceinline__ float lo_bf(unsigned w) { return __uint_as_float(w << 16); }
__device__ __forceinline__ float hi_bf(unsigned w) { return __uint_as_float(w & 0xffff0000u); }
__device__ __forceinline__ float sigmoidf_(float x) { return __builtin_amdgcn_rcpf(1.f + __expf(-x)); }
__device__ __forceinline__ float siluf_(float x) { return x * __builtin_amdgcn_rcpf(1.f + __expf(-x)); }

__device__ __forceinline__ int opaque_tid() { int t = threadIdx.x; asm volatile("" : "+v"(t)); return t; }

namespace pg8 {
#define PG8_LAS __attribute__((address_space(3)))
typedef unsigned short bf16_t;
typedef short bf16x8 __attribute__((ext_vector_type(8)));
typedef float f32x4 __attribute__((ext_vector_type(4)));
typedef unsigned u32x4 __attribute__((ext_vector_type(4)));
constexpr int BM = 256, BK = 64, HALF = 128, HTB = HALF * BK * 2  , STAGE_BYTES = 8 * HTB, NXCD = 8, WGM = 8;

__host__ __device__ __forceinline__ int lds_byte(int r, int c) { const int st = (r >> 4) * 2 + (c >> 5), rr = r & 15, cc = c & 31, ob = rr * 64 + cc * 2; return st * 1024 + (ob ^ (((ob >> 9) & 1) << 5)); }
__host__ __device__ __forceinline__ void stage_rc(int b, int& R, int& C) { const int st = b / 1024, sb = b % 1024, swz = sb ^ (((sb >> 9) & 1) << 5); R = (st >> 1) * 16 + swz / 64; C = (st & 1) * 32 + (swz % 64) / 2; }
__host__ __device__ __forceinline__ int perm32(int rho) { const int n = rho >> 4, i = rho & 15; return 8 * (i >> 2) + 4 * n + (i & 3); }

struct Unit { int pm, pn; };
struct Gemm { const bf16_t* A; const bf16_t* Bt; int M, N, K; const bf16_t* A2; const bf16_t* Bt2; };

struct StaticOrder {
    int nM, nN, nwg, G, c;
    __host__ __device__ void init(int M, int N, int G_, int c_) { nM = M / BM; nN = N / BM; nwg = nM * nN; G = G_; c = c_; }
    __host__ __device__ bool next(int i, Unit& u) const {
        const long L = (long)i * G + c; if (L >= nwg) return false;
        int wgid = (int)L; { const int q = nwg / NXCD, r = nwg % NXCD, xcd = wgid % NXCD, off = wgid / NXCD; wgid = (xcd < r ? xcd * (q + 1) : r * (q + 1) + (xcd - r) * q) + off; }
        const int nig = WGM * nN, gid = wgid / nig, fm = gid * WGM, gsz = (nM - fm) < WGM ? (nM - fm) : WGM;
        u.pm = fm + ((wgid % nig) % gsz); u.pn = (wgid % nig) / gsz; return true;
    }
    __device__ __forceinline__ void a_ready(const Unit&) const {}
    __device__ __forceinline__ void done(const Unit&) const {}
};
template <class Epi, class Sched, bool ALIGN_EPI = false, bool SP2 = false, bool DUAL = false>
__device__ __forceinline__ void gemm_phase(PG8_LAS unsigned char* lds, const Gemm g, const Sched& S, const Epi& E) {
    const int tid = opaque_tid(), wid = __builtin_amdgcn_readfirstlane(tid >> 6), lane = tid & 63, wr = wid >> 2, wc = wid & 3, fr = lane & 15, fq = lane >> 4;
    const int K = g.K, nh = K / BK, nt = DUAL ? 2 * nh : nh;
    unsigned voffA[2], voffB[2];
#pragma unroll
    for (int i = 0; i < 2; ++i) { int R, C; stage_rc(tid * 16 + i * 8192, R, C); const int Rb = Epi::PERM ? ((R & ~31) + perm32(R & 31)) : R;
        voffA[i] = (unsigned)(R * K + C) * 2u; voffB[i] = (unsigned)(Rb * K + C) * 2u; }
    const size_t kstep = (size_t)(BK * 2);
    const size_t hstep = (size_t)HALF * K * 2;
    const size_t tstep = 2 * hstep;
    const unsigned ldsw = (unsigned)wid * 1024u;
    const int aoff = lds_byte(wr * 64 + fr, fq * 8), boff = lds_byte(wc * 32 + fr, fq * 8);
#define PG8_SA(b, h) (((b) * 2 + (h)) * HTB)
#define PG8_SB(b, h) ((4 + (b) * 2 + (h)) * HTB)
#define PG8_STAGE(bufoff, gbase, voff) do { _Pragma("unroll") for (int _i = 0; _i < 2; ++_i) \
        __builtin_amdgcn_global_load_lds((const unsigned*)((const char*)(gbase) + (voff)[_i]), (PG8_LAS unsigned*)(lds + (bufoff) + ldsw + _i * 8192), 16, 0, 0); } while (0)
#define PG8_LDA(dst, b, h) do { _Pragma("unroll") for (int m = 0; m < 4; ++m) _Pragma("unroll") for (int k = 0; k < 2; ++k) dst[m][k] = *(const PG8_LAS bf16x8*)(lds + PG8_SA(b, h) + aoff + m * 2048 + k * 1024); } while (0)
#define PG8_LDB(dst, b, h) do { _Pragma("unroll") for (int n = 0; n < 2; ++n) _Pragma("unroll") for (int k = 0; k < 2; ++k) dst[n][k] = *(const PG8_LAS bf16x8*)(lds + PG8_SB(b, h) + boff + n * 2048 + k * 1024); } while (0)
#define PG8_MMA(ai, bj, At, Bt) do { __builtin_amdgcn_s_setprio(1); _Pragma("unroll") for (int m = 0; m < 4; ++m) _Pragma("unroll") for (int n = 0; n < 2; ++n) _Pragma("unroll") for (int k = 0; k < 2; ++k) \
        acc[ai][bj][m][n] = __builtin_amdgcn_mfma_f32_16x16x32_bf16(Bt[n][k], At[m][k], acc[ai][bj][m][n], 0, 0, 0); __builtin_amdgcn_s_setprio(0); } while (0)
#define PG8_WAIT_V(n) asm volatile("s_waitcnt vmcnt(" #n ")" ::: "memory")
#define PG8_WAIT_L(n) asm volatile("s_waitcnt lgkmcnt(" #n ")" ::: "memory")
#define PG8_BAR __builtin_amdgcn_s_barrier()
#define PG8_SCHED __builtin_amdgcn_sched_barrier(0)
    Unit cur, nxt; int ui = 0;
    if (!S.next(0, cur)) return;
    f32x4 acc[2][2][4][2];
#pragma unroll
    for (int a = 0; a < 2; ++a)
#pragma unroll
        for (int b = 0; b < 2; ++b)
#pragma unroll
            for (int m = 0; m < 4; ++m)
#pragma unroll
                for (int n = 0; n < 2; ++n) acc[a][b][m][n] = (f32x4){0.f, 0.f, 0.f, 0.f};
    bf16x8 At[4][2], B0[2][2], B1[2][2];
    const char* cA = (const char*)g.A + (size_t)cur.pm * tstep; const char* cB = (const char*)g.Bt + (size_t)cur.pn * tstep;
    const char* uA = cA; const char* uB = cB;
    S.a_ready(cur);
    if constexpr (SP2) {
        PG8_STAGE(PG8_SB(0, 0), cB, voffB); PG8_STAGE(PG8_SB(0, 1), cB + hstep, voffB); PG8_STAGE(PG8_SA(0, 0), cA, voffA); PG8_STAGE(PG8_SA(0, 1), cA + hstep, voffA);
        if (wr == 1) PG8_BAR;
        PG8_WAIT_V(2); PG8_BAR;
        PG8_STAGE(PG8_SB(1, 0), cB + kstep, voffB); PG8_STAGE(PG8_SA(1, 0), cA + kstep, voffA); PG8_STAGE(PG8_SB(1, 1), cB + hstep + kstep, voffB);
        PG8_WAIT_V(6); PG8_BAR;
    } else {
        PG8_STAGE(PG8_SB(0, 0), cB, voffB); PG8_STAGE(PG8_SA(0, 0), cA, voffA); PG8_STAGE(PG8_SB(0, 1), cB + hstep, voffB); PG8_STAGE(PG8_SA(0, 1), cA + hstep, voffA);
        if (wr == 1) PG8_BAR;
        PG8_WAIT_V(4); PG8_BAR;
        PG8_STAGE(PG8_SB(1, 0), cB + kstep, voffB); PG8_STAGE(PG8_SA(1, 0), cA + kstep, voffA); PG8_STAGE(PG8_SB(1, 1), cB + hstep + kstep, voffB);
        PG8_WAIT_V(6); PG8_BAR;
    }
    for (;;) {
        const bool has_next = S.next(ui + 1, nxt);
        const char* nA = has_next ? (const char*)g.A + (size_t)nxt.pm * tstep : uA; const char* nB = has_next ? (const char*)g.Bt + (size_t)nxt.pn * tstep : uB;
        const char* sA = DUAL ? (const char*)g.A2 + (size_t)cur.pm * tstep : uA; const char* sB = DUAL ? (const char*)g.Bt2 + (size_t)cur.pn * tstep : uB;
        for (int t = 0; t < nt; t += 2) {
            const bool last = (t == nt - 2);
            const bool seam = DUAL && (t == nh - 2);
            if constexpr (DUAL) { if (t == nh) { cA = sA - (size_t)nh * kstep; cB = sB - (size_t)nh * kstep; E.mid(acc, cur, wr, wc, fr, fq); } }
            const char* a1 = cA + (size_t)(t + 1) * kstep;
            const char* a2 = last ? nA : (seam ? sA : cA + (size_t)(t + 2) * kstep); const char* b2 = last ? nB : (seam ? sB : cB + (size_t)(t + 2) * kstep);
            const char* a3 = a2 + kstep; const char* b3 = b2 + kstep;
            if (last && has_next) S.a_ready(nxt);
            if constexpr (SP2) {
            PG8_LDB(B0, 0, 0); PG8_LDB(B1, 0, 1); PG8_SCHED; PG8_LDA(At, 0, 0); PG8_STAGE(PG8_SA(1, 1), a1 + hstep, voffA);
            PG8_WAIT_V(8); PG8_WAIT_L(0); PG8_BAR; PG8_MMA(0, 0, At, B0); PG8_MMA(0, 1, At, B1); PG8_BAR; PG8_SCHED;
            PG8_LDA(At, 0, 1); PG8_STAGE(PG8_SB(0, 0), b2, voffB); PG8_STAGE(PG8_SB(0, 1), b2 + hstep, voffB); PG8_STAGE(PG8_SA(0, 0), a2, voffA);
            PG8_WAIT_V(8); PG8_WAIT_L(0); PG8_BAR; PG8_MMA(1, 0, At, B0); PG8_MMA(1, 1, At, B1); PG8_BAR; PG8_SCHED;
            PG8_LDB(B0, 1, 0); PG8_LDB(B1, 1, 1); PG8_SCHED; PG8_LDA(At, 1, 0); PG8_STAGE(PG8_SA(0, 1), a2 + hstep, voffA);
            PG8_WAIT_V(8); PG8_WAIT_L(0); PG8_BAR; PG8_MMA(0, 0, At, B0); PG8_MMA(0, 1, At, B1); PG8_BAR; PG8_SCHED;
            PG8_LDA(At, 1, 1); PG8_STAGE(PG8_SB(1, 0), b3, voffB); PG8_STAGE(PG8_SB(1, 1), b3 + hstep, voffB); PG8_STAGE(PG8_SA(1, 0), a3, voffA);
            PG8_WAIT_V(8); PG8_WAIT_L(0); PG8_BAR; PG8_MMA(1, 0, At, B0); PG8_MMA(1, 1, At, B1); PG8_BAR; PG8_SCHED;
            } else {
            PG8_LDB(B0, 0, 0); PG8_SCHED; PG8_LDA(At, 0, 0); PG8_STAGE(PG8_SA(1, 1), a1 + hstep, voffA);
            PG8_WAIT_L(8); PG8_BAR; PG8_WAIT_L(0); PG8_MMA(0, 0, At, B0); PG8_BAR; PG8_SCHED;
            PG8_LDB(B1, 0, 1); PG8_STAGE(PG8_SB(0, 0), b2, voffB);
            PG8_BAR; PG8_WAIT_L(0); PG8_MMA(0, 1, At, B1); PG8_BAR;
            PG8_LDA(At, 0, 1); PG8_STAGE(PG8_SA(0, 0), a2, voffA);
            PG8_BAR; PG8_WAIT_L(0); PG8_MMA(1, 0, At, B0); PG8_BAR; PG8_SCHED;
            PG8_STAGE(PG8_SB(0, 1), b2 + hstep, voffB);
            PG8_WAIT_V(6); PG8_BAR; PG8_MMA(1, 1, At, B1); PG8_BAR;
            PG8_LDB(B0, 1, 0); PG8_SCHED; PG8_LDA(At, 1, 0); PG8_STAGE(PG8_SA(0, 1), a2 + hstep, voffA);
            PG8_WAIT_L(8); PG8_BAR; PG8_WAIT_L(0); PG8_MMA(0, 0, At, B0); PG8_BAR; PG8_SCHED;
            PG8_LDB(B1, 1, 1); PG8_STAGE(PG8_SB(1, 0), b3, voffB);
            PG8_BAR; PG8_WAIT_L(0); PG8_MMA(0, 1, At, B1); PG8_BAR;
            PG8_LDA(At, 1, 1); PG8_STAGE(PG8_SA(1, 0), a3, voffA);
            PG8_BAR; PG8_WAIT_L(0); PG8_MMA(1, 0, At, B0); PG8_BAR; PG8_SCHED;
            PG8_STAGE(PG8_SB(1, 1), b3 + hstep, voffB);
            PG8_WAIT_V(6); PG8_BAR; PG8_MMA(1, 1, At, B1); PG8_BAR;
            }
        }
        if constexpr (ALIGN_EPI) { if (wr == 0) PG8_BAR; }
        if constexpr (!Epi::AFTER_DRAIN) { E(acc, cur, wr, wc, fr, fq); S.done(cur); }
        if (!has_next) break;
#pragma unroll
        for (int a = 0; a < 2; ++a)
#pragma unroll
            for (int b = 0; b < 2; ++b)
#pragma unroll
                for (int m = 0; m < 4; ++m)
#pragma unroll
                    for (int n = 0; n < 2; ++n) acc[a][b][m][n] = (f32x4){0.f, 0.f, 0.f, 0.f};
        cur = nxt; cA = nA; cB = nB; uA = nA; uB = nB; ++ui;
        if constexpr (ALIGN_EPI) { if (wr == 1) PG8_BAR; }
    }
    PG8_WAIT_V(0);
    if constexpr (!ALIGN_EPI) { if (wr == 0) PG8_BAR; }
    PG8_BAR;
    if constexpr (Epi::AFTER_DRAIN) { E.fused(acc, cur, wr, wc, fr, fq, lds, wid, lane); S.done(cur); }
#undef PG8_SA
#undef PG8_SB
#undef PG8_STAGE
#undef PG8_LDA
#undef PG8_LDB
#undef PG8_MMA
#undef PG8_WAIT_V
#undef PG8_WAIT_L
#undef PG8_BAR
#undef PG8_SCHED
}
}

namespace pg8 {
#define EPI_ROWS_BEGIN  _Pragma("unroll") for (int ai = 0; ai < 2; ++ai) _Pragma("unroll") for (int m = 0; m < 4; ++m) { const int row = u.pm * BM + ai * HALF + wr * 64 + m * 16 + fr;
#define EPI_ROWS_END    }
__device__ __forceinline__ u32x4 pack8(const f32x4& v0, const f32x4& v1) { u32x4 w; w.x = cvtpk2(v0[0], v0[1]); w.y = cvtpk2(v0[2], v0[3]); w.z = cvtpk2(v1[0], v1[1]); w.w = cvtpk2(v1[2], v1[3]); return w; }
__device__ __forceinline__ void unpack8(const u32x4& w, f32x4& v0, f32x4& v1) { v0[0] = lo_bf(w.x); v0[1] = hi_bf(w.x); v0[2] = lo_bf(w.y); v0[3] = hi_bf(w.y); v1[0] = lo_bf(w.z); v1[1] = hi_bf(w.z); v1[2] = lo_bf(w.w); v1[3] = hi_bf(w.w); }

typedef unsigned u32x2g __attribute__((ext_vector_type(2)));
__device__ __forceinline__ float ub(unsigned w, int k) { return (float)((w >> (8 * k)) & 0xffu); }
struct EpiProj {
    static constexpr bool PERM = true, AFTER_DRAIN = false;
    unsigned char* ws;
    __device__ __forceinline__ void operator()(const f32x4 (&acc)[2][2][4][2], const Unit& u, int wr, int wc, int fr, int fq) const {
        const int pn = u.pn;
        u16* base; int ld, ct;
        if (pn < 16) {
            unsigned char* gb8 = ws + (pn < 8 ? WS_GA : WS_GB); const int c0 = (pn & 7) * BM + wc * 32 + 8 * fq;
            EPI_ROWS_BEGIN
                _Pragma("unroll") for (int bj = 0; bj < 2; ++bj) { unsigned w[2];
                    _Pragma("unroll") for (int n = 0; n < 2; ++n) { unsigned q[4];
                        _Pragma("unroll") for (int j = 0; j < 4; ++j) q[j] = (unsigned)(sigmoidf_(acc[ai][bj][m][n][j]) * 255.f + 0.5f);
                        w[n] = q[0] | (q[1] << 8) | (q[2] << 16) | (q[3] << 24); }
                    u32x2g o; o.x = w[0]; o.y = w[1]; *(u32x2g*)(gb8 + (size_t)row * 2048 + c0 + bj * HALF) = o; }
            EPI_ROWS_END
            return;
        }
        if (pn < 24) { base = (u16*)(ws + WS_Z); ld = 2048; ct = pn - 16; }
        else if (pn < 32) { base = (u16*)(ws + WS_Q); ld = 2048; ct = pn - 24; }
        else if (pn < 34) { base = (u16*)(ws + WS_K); ld = 512; ct = pn - 32; }
        else if (pn < 36) { base = (u16*)(ws + WS_V); ld = 512; ct = pn - 34; }
        else { base = (u16*)(ws + WS_R0); ld = 4096; ct = pn - 36; }
        const int col0 = ct * BM + wc * 32 + 8 * fq;
        EPI_ROWS_BEGIN u16* rowp = base + (size_t)row * ld + col0;
            _Pragma("unroll") for (int bj = 0; bj < 2; ++bj) *(u32x4*)(rowp + bj * HALF) = pack8(acc[ai][bj][m][0], acc[ai][bj][m][1]);
        EPI_ROWS_END
    }
};
#define EPI_ROW(ai, m) (u.pm * BM + (ai) * HALF + wr * 64 + (m) * 16 + fr)
template <int SECOND> struct EpiGate {
    static constexpr bool PERM = true, AFTER_DRAIN = false;
    u16* G; const u16* H;
    __device__ __forceinline__ void operator()(const f32x4 (&acc)[2][2][4][2], const Unit& u, int wr, int wc, int fr, int fq) const {
        const int col0 = u.pn * BM + wc * 32 + 8 * fq;
#pragma unroll
        for (int ai = 0; ai < 2; ++ai) {
            u32x4 gq[4][2], hq[4][2];
#pragma unroll
            for (int m = 0; m < 4; ++m)
#pragma unroll
                for (int bj = 0; bj < 2; ++bj) { const size_t off = (size_t)EPI_ROW(ai, m) * DM + col0 + bj * HALF;
                    gq[m][bj] = *(const u32x4*)(G + off); if (SECOND) hq[m][bj] = *(const u32x4*)(H + off); }
#pragma unroll
            for (int m = 0; m < 4; ++m)
#pragma unroll
                for (int bj = 0; bj < 2; ++bj) { const size_t off = (size_t)EPI_ROW(ai, m) * DM + col0 + bj * HALF;
                    f32x4 g0, g1; unpack8(gq[m][bj], g0, g1); f32x4 r0, r1;
                    if (SECOND == 0) {
#pragma unroll
                        for (int j = 0; j < 4; ++j) { r0[j] = sigmoidf_(g0[j]) * acc[ai][bj][m][0][j]; r1[j] = sigmoidf_(g1[j]) * acc[ai][bj][m][1][j]; } }
                    else { f32x4 h0, h1; unpack8(hq[m][bj], h0, h1);
#pragma unroll
                        for (int j = 0; j < 4; ++j) { r0[j] = g0[j] + sigmoidf_(h0[j]) * acc[ai][bj][m][0][j]; r1[j] = g1[j] + sigmoidf_(h1[j]) * acc[ai][bj][m][1][j]; } }
                    *(u32x4*)(G + off) = pack8(r0, r1); }
        }
    }
};
struct EpiGate2 {
    static constexpr bool PERM = true, AFTER_DRAIN = false;
    const unsigned char* SA; const unsigned char* SB; u16* MG;
    __device__ __forceinline__ void mid(f32x4 (&acc)[2][2][4][2], const Unit& u, int wr_, int wc_, int fr_, int fq_) const {
        const int ot = opaque_tid(), wr = __builtin_amdgcn_readfirstlane(ot >> 8), wc = __builtin_amdgcn_readfirstlane((ot >> 6) & 3), fr = ot & 15, fq = (ot >> 4) & 3;
        const int col0 = u.pn * BM + wc * 32 + 8 * fq;
#pragma unroll
        for (int ai = 0; ai < 2; ++ai) {
            u32x2g aq[4][2], bq[4][2];
#pragma unroll
            for (int m = 0; m < 4; ++m)
#pragma unroll
                for (int bj = 0; bj < 2; ++bj) { const size_t off = (size_t)EPI_ROW(ai, m) * 2048 + col0 + bj * HALF; aq[m][bj] = *(const u32x2g*)(SA + off); bq[m][bj] = *(const u32x2g*)(SB + off); }
#pragma unroll
            for (int m = 0; m < 4; ++m)
#pragma unroll
                for (int bj = 0; bj < 2; ++bj)
#pragma unroll
                    for (int j = 0; j < 4; ++j) { acc[ai][bj][m][0][j] *= ub(aq[m][bj].x, j) * __builtin_amdgcn_rcpf(fmaxf(ub(bq[m][bj].x, j), 0.5f));
                                                  acc[ai][bj][m][1][j] *= ub(aq[m][bj].y, j) * __builtin_amdgcn_rcpf(fmaxf(ub(bq[m][bj].y, j), 0.5f)); }
        }
    }
    __device__ __forceinline__ void operator()(const f32x4 (&acc)[2][2][4][2], const Unit& u, int wr_, int wc_, int fr_, int fq_) const {
        const int ot = opaque_tid(), wr = __builtin_amdgcn_readfirstlane(ot >> 8), wc = __builtin_amdgcn_readfirstlane((ot >> 6) & 3), fr = ot & 15, fq = (ot >> 4) & 3;
        const int col0 = u.pn * BM + wc * 32 + 8 * fq;
#pragma unroll
        for (int ai = 0; ai < 2; ++ai) {
            u32x2g bq[4][2];
#pragma unroll
            for (int m = 0; m < 4; ++m)
#pragma unroll
                for (int bj = 0; bj < 2; ++bj) bq[m][bj] = *(const u32x2g*)(SB + (size_t)EPI_ROW(ai, m) * 2048 + col0 + bj * HALF);
#pragma unroll
            for (int m = 0; m < 4; ++m)
#pragma unroll
                for (int bj = 0; bj < 2; ++bj) { f32x4 r0, r1;
#pragma unroll
                    for (int j = 0; j < 4; ++j) { r0[j] = fmaxf(ub(bq[m][bj].x, j), 0.5f) * (1.f / 255.f) * acc[ai][bj][m][0][j]; r1[j] = fmaxf(ub(bq[m][bj].y, j), 0.5f) * (1.f / 255.f) * acc[ai][bj][m][1][j]; }
                    *(u32x4*)(MG + (size_t)EPI_ROW(ai, m) * DM + col0 + bj * HALF) = pack8(r0, r1); }
        }
    }
};
struct EpiRes {
    static constexpr bool PERM = true, AFTER_DRAIN = false;
    const float* R32; float* O32; u16* O16; float* ssq;
    __device__ __forceinline__ void operator()(const f32x4 (&acc)[2][2][4][2], const Unit& u, int wr, int wc, int fr, int fq) const {
        const int col0 = u.pn * BM + wc * 32 + 8 * fq;
#pragma unroll
        for (int ai = 0; ai < 2; ++ai) {
            f32x4 rq[4][2][2];
#pragma unroll
            for (int m = 0; m < 4; ++m)
#pragma unroll
                for (int bj = 0; bj < 2; ++bj) { const size_t off = (size_t)EPI_ROW(ai, m) * DM + col0 + bj * HALF; rq[m][bj][0] = *(const f32x4*)(R32 + off); rq[m][bj][1] = *(const f32x4*)(R32 + off + 4); }
#pragma unroll
            for (int m = 0; m < 4; ++m) { const int row = EPI_ROW(ai, m); float s = 0.f;
#pragma unroll
                for (int bj = 0; bj < 2; ++bj) { const size_t off = (size_t)row * DM + col0 + bj * HALF;
                    const f32x4 r0 = rq[m][bj][0] + acc[ai][bj][m][0], r1 = rq[m][bj][1] + acc[ai][bj][m][1];
                    *(f32x4*)(O32 + off) = r0; *(f32x4*)(O32 + off + 4) = r1;
                    if (O16) *(u32x4*)(O16 + off) = pack8(r0, r1);
#pragma unroll
                    for (int j = 0; j < 4; ++j) s += r0[j] * r0[j] + r1[j] * r1[j]; }
                s += __shfl_xor(s, 16); s += __shfl_xor(s, 32);
                if (fq == 0) ssq[(size_t)row * 32 + u.pn * 4 + wc] = s; }
        }
    }
};
template <int MODE> struct EpiResB {
    static constexpr bool PERM = true, AFTER_DRAIN = false;
    const float* R32; u16* X16; float* ssq;
    __device__ __forceinline__ void operator()(const f32x4 (&acc)[2][2][4][2], const Unit& u, int wr, int wc, int fr, int fq) const {
        const int col0 = u.pn * BM + wc * 32 + 8 * fq;
#pragma unroll
        for (int ai = 0; ai < 2; ++ai) {
            f32x4 rq[4][2][2];
#pragma unroll
            for (int m = 0; m < 4; ++m)
#pragma unroll
                for (int bj = 0; bj < 2; ++bj) { const size_t off = (size_t)EPI_ROW(ai, m) * DM + col0 + bj * HALF;
                    if (MODE == 0) { rq[m][bj][0] = *(const f32x4*)(R32 + off); rq[m][bj][1] = *(const f32x4*)(R32 + off + 4); }
                    else unpack8(*(const u32x4*)(X16 + off), rq[m][bj][0], rq[m][bj][1]); }
#pragma unroll
            for (int m = 0; m < 4; ++m) { const int row = EPI_ROW(ai, m); float s = 0.f;
#pragma unroll
                for (int bj = 0; bj < 2; ++bj) { const size_t off = (size_t)row * DM + col0 + bj * HALF;
                    const f32x4 r0 = rq[m][bj][0] + acc[ai][bj][m][0], r1 = rq[m][bj][1] + acc[ai][bj][m][1];
                    *(u32x4*)(X16 + off) = pack8(r0, r1);
#pragma unroll
                    for (int j = 0; j < 4; ++j) s += r0[j] * r0[j] + r1[j] * r1[j]; }
                s += __shfl_xor(s, 16); s += __shfl_xor(s, 32);
                if (fq == 0) ssq[(size_t)row * 32 + u.pn * 4 + wc] = s; }
        }
    }
};
struct EpiMlpIn {
    static constexpr bool PERM = true, AFTER_DRAIN = false;
    u16* U; const float* ssq;
    __device__ __forceinline__ void operator()(const f32x4 (&acc)[2][2][4][2], const Unit& u, int wr, int wc, int fr, int fq) const {
        const int col0 = u.pn * BM + wc * 32 + 8 * fq;
        f32x4 pq[2][4][2];
#pragma unroll
        for (int ai = 0; ai < 2; ++ai)
#pragma unroll
            for (int m = 0; m < 4; ++m) { const float* sp = ssq + (size_t)EPI_ROW(ai, m) * 32 + fq * 8; pq[ai][m][0] = *(const f32x4*)sp; pq[ai][m][1] = *(const f32x4*)(sp + 4); }
#pragma unroll
        for (int ai = 0; ai < 2; ++ai)
#pragma unroll
            for (int m = 0; m < 4; ++m) { const int row = EPI_ROW(ai, m);
                const f32x4 p0 = pq[ai][m][0], p1 = pq[ai][m][1];
                float s = (p0[0] + p0[1]) + (p0[2] + p0[3]) + (p1[0] + p1[1]) + (p1[2] + p1[3]);
                s += __shfl_xor(s, 16); s += __shfl_xor(s, 32);
                const float rstd = __builtin_amdgcn_rsqf(s * (1.f / DM) + EPSN);
#pragma unroll
                for (int bj = 0; bj < 2; ++bj) { f32x4 r0, r1;
#pragma unroll
                    for (int j = 0; j < 4; ++j) { const float a = fmaxf(acc[ai][bj][m][0][j] * rstd, 0.f), b = fmaxf(acc[ai][bj][m][1][j] * rstd, 0.f); r0[j] = a * a; r1[j] = b * b; }
                    *(u32x4*)(U + (size_t)row * DFF + col0 + bj * HALF) = pack8(r0, r1); } }
    }
};
}

#define XB_TMO      128
#define XB_XCNT(j)  (256  + 64 * (j))
#define XB_XSUB(j)  (1280 + 64 * (j))
#define XB_XGEN(j)  (2304 + 64 * (j))
#define XB_TOP      3328
#define XB_TOPGEN   3392
#define XCD_BAR_WORDS 3456
#define XB_SPIN_CAP (1u << 18)
#define LAS __attribute__((address_space(3)))

__device__ __forceinline__ unsigned xb_ld(unsigned* p)              { return __hip_atomic_load(p, __ATOMIC_RELAXED, __HIP_MEMORY_SCOPE_AGENT); }
__device__ __forceinline__ unsigned xb_add(unsigned* p, unsigned v) { return __hip_atomic_fetch_add(p, v, __ATOMIC_RELAXED, __HIP_MEMORY_SCOPE_AGENT); }
__device__ __forceinline__ unsigned xb_xcc_id() { return (unsigned)__builtin_amdgcn_s_getreg((3 << 11) | 20) & 0xFu; }
#define XB_SPIN(cond, bar) do { unsigned _sp = 0; while (cond) { __builtin_amdgcn_s_sleep(1); \
    if ((++_sp & 255u) == 0u) { if (xb_ld(&(bar)[XB_TMO])) break; if (_sp > XB_SPIN_CAP) { atomicAdd(&(bar)[XB_TMO], 1u); break; } } } } while (0)

struct XcdBarrier {
    unsigned* bar; unsigned x;
    volatile LAS unsigned* st;
};

__device__ __forceinline__ XcdBarrier xcd_barrier_post(unsigned* bar, volatile LAS unsigned* st) {
    XcdBarrier b; b.bar = bar; b.x = xb_xcc_id(); b.st = st;
    if (threadIdx.x == 0) (void)xb_add(&bar[XB_XCNT(b.x)], 1u);
    return b;
}
__device__ __forceinline__ void xcd_barrier_complete(unsigned* bar, unsigned x, unsigned& nloc, unsigned& nx) {
    const unsigned G = gridDim.x * gridDim.y * gridDim.z;
    unsigned sum, cnt, mine, sp = 0u;
    for (;;) {
        sum = 0u; cnt = 0u; mine = 0u;
#pragma unroll
        for (unsigned j = 0; j < 16; ++j) { const unsigned c = xb_ld(&bar[XB_XCNT(j)]); sum += c; cnt += (c > 0u) ? 1u : 0u; mine = (j == x) ? c : mine; }
        if (sum == G) break;
        __builtin_amdgcn_s_sleep(1);
        if ((++sp & 255u) == 0u) { if (xb_ld(&bar[XB_TMO])) break; if (sp > XB_SPIN_CAP) { atomicAdd(&bar[XB_TMO], 1u); break; } }
    }
    nloc = mine > 0u ? mine : 1u; nx = cnt > 0u ? cnt : 1u;
}

__device__ __forceinline__ void xcd_barrier(const XcdBarrier& b) {
    asm volatile("s_waitcnt vmcnt(0)" ::: "memory");
    __syncthreads();
    if (threadIdx.x == 0) {
        unsigned* bar = b.bar;
        __builtin_amdgcn_s_waitcnt(0);
        unsigned nloc = b.st[0], nx = b.st[1];
        if (nloc == 0u) { xcd_barrier_complete(bar, b.x, nloc, nx); b.st[0] = nloc; b.st[1] = nx; }
        const unsigned old = xb_add(&bar[XB_XSUB(b.x)], 1u);
        const unsigned gen = old / nloc;
        if (old + 1u == (gen + 1u) * nloc) {
            __builtin_amdgcn_fence(__ATOMIC_RELEASE, "agent");
            asm volatile("s_waitcnt vmcnt(0)" ::: "memory");
            const unsigned og = xb_add(&bar[XB_TOP], 1u);
            const unsigned tg = og / nx;
            if (og + 1u == (tg + 1u) * nx) xb_add(&bar[XB_TOPGEN], 1u);
            else XB_SPIN(xb_ld(&bar[XB_TOPGEN]) == tg, bar);
            __builtin_amdgcn_fence(__ATOMIC_ACQUIRE, "agent");
            xb_add(&bar[XB_XGEN(b.x)], 1u);
            asm volatile("s_waitcnt vmcnt(0)" ::: "memory");
        } else {
            XB_SPIN(xb_ld(&bar[XB_XGEN(b.x)]) == gen, bar);
            __builtin_amdgcn_fence(__ATOMIC_ACQUIRE, "agent");
            asm volatile("s_waitcnt vmcnt(0)" ::: "memory");
        }
    }
    __syncthreads();
}

namespace att {
using bf16 = __hip_bfloat16;
constexpr int   D = 128, NW = 8, QBLK = 32, KVBLK = 64;
constexpr float SCALE = 0.088388347648318440f;
constexpr float THR = 8.f;
constexpr int SDEPTH = 2;
constexpr int LDQ = 2048, LDK = 512, LDO = 2048;
constexpr size_t SHM_V = KVBLK * D * 2, SHM_K = KVBLK * D * 2, SHM_ATTN = 2 * SHM_V + 2 * SHM_K + NW * 64 * 4;
using bf16x8 = __attribute__((ext_vector_type(8))) short;
using s16x4  = __attribute__((ext_vector_type(4))) short;
using f32x16 = __attribute__((ext_vector_type(16))) float;
using f32x8  = __attribute__((ext_vector_type(8))) float;
using u32x4  = __attribute__((ext_vector_type(4))) unsigned;
#define KSWZ(row, colB) ((row) * 256 + ((colB) ^ (((row) & 7) << 4)))
#define SBAR() __builtin_amdgcn_sched_barrier(0)
__device__ __forceinline__ int crow(int r, int hi) { return (r & 3) + 8 * (r >> 2) + 4 * hi; }
__device__ __forceinline__ unsigned cvtpk(float lo, float hi) {
  unsigned r; asm volatile("v_cvt_pk_bf16_f32 %0, %1, %2" : "=v"(r) : "v"(lo), "v"(hi)); return r;
}
template <typename TIn> struct Stage;
template <> struct Stage<bf16>  { using T = bf16x8;
  __device__ static __forceinline__ T ld8(const bf16* p) { return *reinterpret_cast<const bf16x8*>(p); }
  __device__ static __forceinline__ bf16x8 tobf(T x) { return x; } };
template <> struct Stage<float> { using T = f32x8;
  __device__ static __forceinline__ T ld8(const float* p) { return *reinterpret_cast<const f32x8*>(p); }
  __device__ static __forceinline__ bf16x8 tobf(T x) {
    u32x4 w = {cvtpk(x[0], x[1]), cvtpk(x[2], x[3]), cvtpk(x[4], x[5]), cvtpk(x[6], x[7])}; return *reinterpret_cast<bf16x8*>(&w); } };

__device__ __forceinline__ void partialSM(f32x16& p0, f32x16& p1, float& m_reg, float& mn, float& alpha) {
  constexpr float C = SCALE * 1.4426950408889634f;
  float pmax = p0[0]; for (int r = 1; r < 16; ++r) pmax = fmaxf(pmax, p0[r]); for (int r = 0; r < 16; ++r) pmax = fmaxf(pmax, p1[r]);
  { auto rr = __builtin_amdgcn_permlane32_swap(__float_as_uint(pmax), __float_as_uint(pmax), false, false);
    pmax = fmaxf(__uint_as_float(rr[0]), __uint_as_float(rr[1])); }
  if (__builtin_expect(__all(pmax - m_reg <= THR / SCALE), 1)) { mn = m_reg; alpha = 1.f; }
  else { mn = fmaxf(m_reg, pmax); alpha = __builtin_amdgcn_exp2f((m_reg - mn) * C); m_reg = mn; }
  float mnC = -mn * C;
  for (int r = 0; r < 16; ++r) p0[r] = fmaf(p0[r], C, mnC); for (int r = 0; r < 16; ++r) p1[r] = fmaf(p1[r], C, mnC);
  for (int r = 0; r < 16; ++r) p0[r] = __builtin_amdgcn_exp2f(p0[r]);
}
__device__ __forceinline__ void finishSM(f32x16& p0, f32x16& p1, float alpha, float& l_reg, bf16x8& pa0, bf16x8& pa1, bf16x8& pa2, bf16x8& pa3) {
  for (int r = 0; r < 16; ++r) p1[r] = __builtin_amdgcn_exp2f(p1[r]);
  float ps = 0; for (int r = 0; r < 16; ++r) ps += p0[r]; for (int r = 0; r < 16; ++r) ps += p1[r];
  { auto rr = __builtin_amdgcn_permlane32_swap(__float_as_uint(ps), __float_as_uint(ps), false, false);
    ps = __uint_as_float(rr[0]) + __uint_as_float(rr[1]); }
  l_reg = l_reg * alpha + ps;
#define PK4(P, BASE, OUT) do { unsigned a0 = cvtpk(P[BASE + 0], P[BASE + 1]), a1 = cvtpk(P[BASE + 2], P[BASE + 3]);   \
    unsigned b0 = cvtpk(P[BASE + 4], P[BASE + 5]), b1 = cvtpk(P[BASE + 6], P[BASE + 7]);                              \
    auto r0 = __builtin_amdgcn_permlane32_swap(a0, b0, false, false); auto r1 = __builtin_amdgcn_permlane32_swap(a1, b1, false, false); \
    u32x4 w = {r0[0], r1[0], r0[1], r1[1]}; OUT = *reinterpret_cast<bf16x8*>(&w); } while (0)
  PK4(p0, 0, pa0); PK4(p0, 8, pa1); PK4(p1, 0, pa2); PK4(p1, 8, pa3);
#undef PK4
}
__device__ __forceinline__ void qkt(f32x16& p0, f32x16& p1, const bf16* Ks, const bf16x8* qr, int r32, int hi) {
  p0 = f32x16{}; p1 = f32x16{};
  for (int d0 = 0; d0 < 8; ++d0) { int cb = (d0 * 16 + hi * 8) * 2;
    bf16x8 b0 = *reinterpret_cast<const bf16x8*>((const char*)Ks + KSWZ(r32, cb));
    bf16x8 b1 = *reinterpret_cast<const bf16x8*>((const char*)Ks + KSWZ(32 + r32, cb));
    p0 = __builtin_amdgcn_mfma_f32_32x32x16_bf16(b0, qr[d0], p0, 0, 0, 0);
    p1 = __builtin_amdgcn_mfma_f32_32x32x16_bf16(b1, qr[d0], p1, 0, 0, 0); }
}
__device__ __forceinline__ int v_st(int k, int c) { const int kk = (k & ~0xC) | ((k & 4) << 1) | ((k & 8) >> 1); return ((kk >> 3) * 4 + (c >> 5)) * 512 + ((kk & 7) * 32 + (c & 31)) * 2; }
__device__ __forceinline__ int v_rd_base(int lane) { return ((lane & 3) << 3) | (((lane >> 2) & 3) << 6) | (((lane >> 4) & 1) << 5) | (((lane >> 5) & 1) << 8); }
constexpr int v_rd_off(int d0, int ks, int half) { return d0 * 512 + ks * 4096 + half * 2048; }
template <int OFF> __device__ __forceinline__ s16x4 tr_read(int vb) {
  s16x4 r; asm volatile("ds_read_b64_tr_b16 %0, %1 offset:%2" : "=&v"(r) : "v"(vb), "i"(OFF) : "memory"); return r;
}
template <int D0> __device__ __forceinline__ void pv_one(f32x16& od, int vb, bf16x8 pa0, bf16x8 pa1, bf16x8 pa2, bf16x8 pa3) {
  const s16x4 l0 = tr_read<v_rd_off(D0, 0, 0)>(vb), h0 = tr_read<v_rd_off(D0, 0, 1)>(vb), l1 = tr_read<v_rd_off(D0, 1, 0)>(vb), h1 = tr_read<v_rd_off(D0, 1, 1)>(vb);
  const s16x4 l2 = tr_read<v_rd_off(D0, 2, 0)>(vb), h2 = tr_read<v_rd_off(D0, 2, 1)>(vb), l3 = tr_read<v_rd_off(D0, 3, 0)>(vb), h3 = tr_read<v_rd_off(D0, 3, 1)>(vb);
  asm volatile("s_waitcnt lgkmcnt(0)" ::: "memory"); SBAR();
#define PK(L, H) (bf16x8){L[0], L[1], L[2], L[3], H[0], H[1], H[2], H[3]}
  od = __builtin_amdgcn_mfma_f32_32x32x16_bf16(pa0, PK(l0, h0), od, 0, 0, 0);
  od = __builtin_amdgcn_mfma_f32_32x32x16_bf16(pa1, PK(l1, h1), od, 0, 0, 0);
  od = __builtin_amdgcn_mfma_f32_32x32x16_bf16(pa2, PK(l2, h2), od, 0, 0, 0);
  od = __builtin_amdgcn_mfma_f32_32x32x16_bf16(pa3, PK(l3, h3), od, 0, 0, 0);
#undef PK
}
__device__ __forceinline__ void pv_d0(f32x16* o, int vb, bf16x8 pa0, bf16x8 pa1, bf16x8 pa2, bf16x8 pa3) {
  pv_one<0>(o[0], vb, pa0, pa1, pa2, pa3); pv_one<1>(o[1], vb, pa0, pa1, pa2, pa3); pv_one<2>(o[2], vb, pa0, pa1, pa2, pa3); pv_one<3>(o[3], vb, pa0, pa1, pa2, pa3);
}

template <typename TQ>
__device__ __forceinline__ void attn_dense_body(const TQ* __restrict__ Qb, const bf16* __restrict__ Kh, const bf16* __restrict__ Vh,
                                                bf16* __restrict__ Ob, int seq, char* lds, const float* __restrict__ qg, const float* __restrict__ rtab, int spos0) {
  using St = Stage<bf16>; using SQ = Stage<TQ>;
  const int tid = opaque_tid(), wid = tid >> 6, lane = tid & 63, r32 = lane & 31, hi = lane >> 5;
  bf16* V_lds = (bf16*)lds; bf16* K_lds = (bf16*)(lds + 2 * SHM_V);
  float* ws = (float*)(lds + 2 * SHM_V + 2 * SHM_K) + wid * 64; float* li_l = ws; float* al_l = ws + 32;
  float m_reg = -1e30f, l_reg = 0; f32x16 o[4] = {}; bf16x8 qr[8];
  const TQ* Qw = Qb + (long)(wid * QBLK + r32) * LDQ + hi * 8;
#pragma unroll
  for (int d0 = 0; d0 < 8; ++d0) qr[d0] = SQ::tobf(SQ::ld8(Qw + d0 * 16));
  {
    float ssq = 0.f;
#pragma unroll
    for (int d0 = 0; d0 < 8; ++d0) { const u32x4 w = *reinterpret_cast<const u32x4*>(&qr[d0]);
#pragma unroll
      for (int e = 0; e < 4; ++e) { const float lo = __uint_as_float(w[e] << 16), hi2 = __uint_as_float(w[e] & 0xffff0000u); ssq += lo * lo + hi2 * hi2; } }
    ssq += __shfl_xor(ssq, 32);
    const float rstd = __builtin_amdgcn_rsqf(ssq * (1.f / 128.f) + 1e-6f);
    const int pos = spos0 + wid * QBLK + r32, prow = pos >> 6, pcol = pos & 63;
#pragma unroll
    for (int d0 = 0; d0 < 8; ++d0) { const int e0 = d0 * 16 + hi * 8, pv = d0 < 4 ? prow : pcol, j0 = (d0 & 3) * 8 + hi * 4;
      const f32x8 g = *reinterpret_cast<const f32x8*>(qg + e0); const f32x8 cs = *reinterpret_cast<const f32x8*>(rtab + (pv * 32 + j0) * 2);
      const u32x4 w = *reinterpret_cast<const u32x4*>(&qr[d0]); u32x4 o;
#pragma unroll
      for (int e = 0; e < 4; ++e) { const float x0 = __uint_as_float(w[e] << 16) * rstd * g[2 * e], x1 = __uint_as_float(w[e] & 0xffff0000u) * rstd * g[2 * e + 1];
        const float c = cs[2 * e], s = cs[2 * e + 1]; o[e] = cvtpk(x0 * c - x1 * s, x0 * s + x1 * c); }
      qr[d0] = *reinterpret_cast<bf16x8*>(&o); } }
  const int sr = tid >> 4, sc = (tid & 15) * 8, vst0 = v_st(sr, sc), vst1 = v_st(32 + sr, sc);
  const int vb0 = (int)(uintptr_t)V_lds + v_rd_base(lane);
  struct { typename St::T vs0, vs1, ks0, ks1; } sr_[SDEPTH];
#define SLOAD(i, k0) do { sr_[i].vs0 = St::ld8(&Vh[(long)((k0) + sr) * LDK + sc]); sr_[i].vs1 = St::ld8(&Vh[(long)((k0) + 32 + sr) * LDK + sc]); \
    sr_[i].ks0 = St::ld8(&Kh[(long)((k0) + sr) * LDK + sc]); sr_[i].ks1 = St::ld8(&Kh[(long)((k0) + 32 + sr) * LDK + sc]); } while (0)
#define SWRITE(b, i) do { *(bf16x8*)((char*)V_lds + (b) * SHM_V + vst0) = St::tobf(sr_[i].vs0);          \
    *(bf16x8*)((char*)V_lds + (b) * SHM_V + vst1) = St::tobf(sr_[i].vs1); int kc = sc * 2;               \
    *(bf16x8*)((char*)K_lds + (b) * SHM_K + KSWZ(sr, kc)) = St::tobf(sr_[i].ks0);                       \
    *(bf16x8*)((char*)K_lds + (b) * SHM_K + KSWZ(32 + sr, kc)) = St::tobf(sr_[i].ks1); } while (0)
#define SWAIT() do { if constexpr (SDEPTH == 2) asm volatile("s_waitcnt vmcnt(4)" ::: "memory"); else asm volatile("s_waitcnt vmcnt(0)" ::: "memory"); } while (0)
#define RESC(a) do { if (__any((a) < 1.f)) { if (hi == 0) al_l[r32] = (a); asm volatile("s_waitcnt lgkmcnt(0)" ::: "memory"); \
    for (int d = 0; d < 4; ++d) for (int r = 0; r < 16; ++r) o[d][r] *= al_l[crow(r, hi)]; } } while (0)
  f32x16 pA0, pA1, pB0, pB1; float mnA, mnB, alA, alB; bf16x8 pa0, pa1, pa2, pa3; const int NT = seq / KVBLK;
  constexpr int SE = 0, SO = SDEPTH - 1;
  SLOAD(SE, 0); asm volatile("s_waitcnt vmcnt(0)" ::: "memory"); SWRITE(0, SE); __syncthreads();
  qkt(pA0, pA1, K_lds, qr, r32, hi); partialSM(pA0, pA1, m_reg, mnA, alA);
  SLOAD(SO, KVBLK); if constexpr (SDEPTH == 2) { if (2 < NT) SLOAD(SE, 2 * KVBLK); }
  SWAIT(); SWRITE(1, SO); __syncthreads();
  for (int j = 1; j + 1 < NT; j += 2) {
    SBAR(); qkt(pB0, pB1, (bf16*)((char*)K_lds + SHM_K), qr, r32, hi);
    finishSM(pA0, pA1, alA, l_reg, pa0, pa1, pa2, pa3); SBAR();
    SLOAD(SO, (j + SDEPTH) * KVBLK); SBAR();
    pv_d0(o, vb0, pa0, pa1, pa2, pa3); partialSM(pB0, pB1, m_reg, mnB, alB);
    __syncthreads(); SWAIT(); SWRITE(0, SE);
    RESC(alB); __syncthreads();
    SBAR(); qkt(pA0, pA1, K_lds, qr, r32, hi);
    finishSM(pB0, pB1, alB, l_reg, pa0, pa1, pa2, pa3); SBAR();
    if (SDEPTH == 1 || j + 3 < NT) SLOAD(SE, (j + 1 + SDEPTH) * KVBLK); SBAR();
    pv_d0(o, vb0 + (int)SHM_V, pa0, pa1, pa2, pa3); partialSM(pA0, pA1, m_reg, mnA, alA);
    __syncthreads(); SWAIT(); SWRITE(1, SO);
    RESC(alA); __syncthreads();
  }
  SBAR(); qkt(pB0, pB1, (bf16*)((char*)K_lds + SHM_K), qr, r32, hi);
  finishSM(pA0, pA1, alA, l_reg, pa0, pa1, pa2, pa3); SBAR();
  pv_d0(o, vb0, pa0, pa1, pa2, pa3); partialSM(pB0, pB1, m_reg, mnB, alB);
  __syncthreads(); RESC(alB);
  finishSM(pB0, pB1, alB, l_reg, pa0, pa1, pa2, pa3); SBAR();
  pv_d0(o, vb0 + (int)SHM_V, pa0, pa1, pa2, pa3);
  if (hi == 0) li_l[r32] = l_reg; asm volatile("s_waitcnt lgkmcnt(0)" ::: "memory");
  float rli[16];
#pragma unroll
  for (int r = 0; r < 16; ++r) rli[r] = __builtin_amdgcn_rcpf(li_l[crow(r, hi)]);
  bf16* Ow = Ob + (long)(wid * QBLK) * LDO;
#pragma unroll
  for (int r = 0; r < 16; ++r) { int orow = crow(r, hi);
    for (int d0 = 0; d0 < 4; ++d0) { unsigned uu = __float_as_uint(o[d0][r] * rli[r]); uu += 0x7fffu + ((uu >> 16) & 1u); ((unsigned short*)Ow)[(long)orow * LDO + d0 * 32 + r32] = (unsigned short)(uu >> 16); } }
#undef SLOAD
#undef SWRITE
#undef SWAIT
#undef RESC
}
}
typedef short bf16x8v __attribute__((ext_vector_type(8)));
typedef float f32x4v __attribute__((ext_vector_type(4)));
typedef unsigned u32x4v __attribute__((ext_vector_type(4)));
#define MFMA16(a, b, c) __builtin_amdgcn_mfma_f32_16x16x32_bf16((a), (b), (c), 0, 0, 0)
__device__ __forceinline__ s16x4v tr_read16(const unsigned char* p) { return __builtin_amdgcn_ds_read_tr16_b64_v4i16((LAS3 s16x4v*)(p)); }
__device__ __forceinline__ bf16x8v pack_bf8(const float* m) { u32x4v w; w.x = cvtpk2(m[0], m[1]); w.y = cvtpk2(m[2], m[3]); w.z = cvtpk2(m[4], m[5]); w.w = cvtpk2(m[6], m[7]); return *reinterpret_cast<bf16x8v*>(&w); }
__device__ __forceinline__ void unpack_bf8(u32x4v w, float* f) { f[0] = lo_bf(w.x); f[1] = hi_bf(w.x); f[2] = lo_bf(w.y); f[3] = hi_bf(w.y); f[4] = lo_bf(w.z); f[5] = hi_bf(w.z); f[6] = lo_bf(w.w); f[7] = hi_bf(w.w); }

__device__ __forceinline__ int win_dest_row(int n) {
    if (n < 2048) return 4096 + n;
    if (n < 6144) return 9216 + (n - 2048);
    if (n < 6208) return 13312 + (n - 6144);
    if (n < 8256) return 6144 + (n - 6208);
    if (n < 8768) return 8192 + (n - 8256);
    if (n < 9280) return 8704 + (n - 8768);
    if (n < 11328) return n - 9280;
    return 2048 + (n - 11328);
}
struct WtDesc { const float* W; u16* Wt; const float* ks; int N, K, k0, n0, drow0; };
__device__ __forceinline__ void wt_load(const WtDesc& d, f32x4v (&v)[4]) {
    const int tid = opaque_tid(), kr = tid >> 3, c4 = tid & 7;
#pragma unroll
    for (int i = 0; i < 4; ++i) { const int k = d.k0 + kr + 64 * i; v[i] = __builtin_nontemporal_load((const f32x4v*)(d.W + (size_t)k * d.N + d.n0 + c4 * 4)); if (d.ks) { const float s = d.ks[k]; v[i] *= s; } }
}
__device__ __forceinline__ void wt_to_lds(const f32x4v (&v)[4], u16* L) {
    const int tid = opaque_tid(), kr = tid >> 3, c4 = tid & 7;
#pragma unroll
    for (int i = 0; i < 4; ++i) { const int kl = kr + 64 * i, ksw = kl ^ ((c4 >> 1) << 3);
#pragma unroll
        for (int e = 0; e < 4; ++e) L[(c4 * 4 + e) * 264 + ksw] = f2bf(v[i][e]); }
}
__device__ __forceinline__ void wt_from_lds(const WtDesc& d, const u16* L) {
    const int tid = opaque_tid(), n = tid >> 4, kk = tid & 15, sw = (n >> 3) & 3;
    const u32x4v a = *(const u32x4v*)(L + n * 264 + (((2 * kk) ^ sw) << 3));
    const u32x4v b = *(const u32x4v*)(L + n * 264 + (((2 * kk + 1) ^ sw) << 3));
    u16* dst = d.Wt + (size_t)(d.drow0 + n) * d.K + d.k0 + kk * 16;
    *(u32x4v*)dst = a; *(u32x4v*)(dst + 8) = b;
}
__device__ __forceinline__ WtDesc wt_desc_prep(const Params& P, int it) {
    unsigned char* ws = P.ws; unsigned char* dob = (unsigned char*)P.out; WtDesc d; d.ks = nullptr;
    if (it < 3344) { const int nt = it >> 3, kt = it & 7; d.W = P.w_in; d.N = NIN; d.K = DM; d.Wt = (u16*)(dob + DO_WIN); d.k0 = kt * 256; d.n0 = nt * 32; d.drow0 = win_dest_row(nt * 32); }
    else { const int j = it - 3344, mat = j >> 9, r = j & 511, nt = r >> 3, kt = r & 7;
        d.W = mat == 0 ? P.w_ssm_up : (mat == 1 ? P.w_attn_up : P.w_out); d.Wt = (u16*)(ws + (mat == 0 ? WS_WSSM : (mat == 1 ? WS_WATT : WS_WOUT)));
        d.N = DM; d.K = DM; d.k0 = kt * 256; d.n0 = nt * 32; d.drow0 = nt * 32; }
    return d;
}
__device__ __forceinline__ WtDesc wt_desc_w1(const Params& P, int it) {
    WtDesc d; const int nt = it >> 3, kt = it & 7; d.W = P.w_mlp_in; d.Wt = (u16*)(P.ws + WS_W1T); d.ks = P.g_mlp; d.N = DFF; d.K = DM; d.k0 = kt * 256; d.n0 = nt * 32; d.drow0 = nt * 32; return d;
}
__device__ __forceinline__ WtDesc wt_desc_w2(const Params& P, int it) {
    WtDesc d; d.ks = nullptr; const int nt = it >> 5, kt = it & 31; d.W = P.w_mlp_out; d.Wt = (u16*)(P.ws + WS_W2T); d.N = DM; d.K = DFF; d.k0 = kt * 256; d.n0 = nt * 32; d.drow0 = nt * 32; return d;
}
template <int WHICH> __device__ __forceinline__ void wt_loop(const Params& P, u16* L, int lo, int hi, int rank, int count) {
    int it = lo + rank; f32x4v vA[4], vB[4]; WtDesc dA{}, dB{};
    u16* L1 = L + 32 * 264;
#define WT_DESC(i_) (WHICH == 0 ? wt_desc_prep(P, (i_)) : (WHICH == 1 ? wt_desc_w1(P, (i_)) : wt_desc_w2(P, (i_))))
    if (it < hi) { dA = WT_DESC(it); wt_load(dA, vA); }
    if (it + count < hi) { dB = WT_DESC(it + count); wt_load(dB, vB); }
    __syncthreads();
    for (; it < hi; it += 2 * count) {
        { wt_to_lds(vA, L);
          __syncthreads();
          const WtDesc dcur = dA; const int itn = it + 2 * count;
          if (itn < hi) { dA = WT_DESC(itn); wt_load(dA, vA); }
          wt_from_lds(dcur, L); }
        if (it + count < hi) {
          wt_to_lds(vB, L1);
          __syncthreads();
          const WtDesc dcur = dB; const int itn = it + 3 * count;
          if (itn < hi) { dB = WT_DESC(itn); wt_load(dB, vB); }
          wt_from_lds(dcur, L1); }
    }
    __syncthreads();
#undef WT_DESC
}
__device__ void phase_prep(const Params& P, unsigned char* lds) {
    u16* L = (u16*)lds; const int tid = opaque_tid(), G = gridDim.x;
    unsigned char* ws = P.ws; unsigned char* dob = (unsigned char*)P.out;
    wt_loop<0>(P, L, 0, 3344 + 1536, blockIdx.x, G);
    for (int e = blockIdx.x * 512 + tid; e < 2048; e += G * 512) { const int pos = e >> 5, j = e & 31;
        double inv = 1.0; for (int q = 0; q < j; ++q) inv *= 0.74989420933245582730;
        const double rev = (double)pos * inv * 0.15915494309189533577; const float fr = (float)(rev - floor(rev));
        float* tab = (float*)(ws + WS_ROPE); tab[2 * e] = __builtin_amdgcn_cosf(fr); tab[2 * e + 1] = __builtin_amdgcn_sinf(fr); }
    { const int lane = tid & 63; u16* H = (u16*)(dob + DO_H);
      int row = blockIdx.x * 8 + (tid >> 6); f32x4v v[8];
      if (row < T_TOK) {
#pragma unroll
          for (int i = 0; i < 8; ++i) v[i] = __builtin_nontemporal_load((const f32x4v*)(P.x + (size_t)row * DM + (i * 64 + lane) * 4)); }
      for (; row < T_TOK; row += G * 8) {
          f32x4v c[8]; float s = 0.f;
#pragma unroll
          for (int i = 0; i < 8; ++i) { c[i] = v[i]; s += c[i][0] * c[i][0] + c[i][1] * c[i][1] + c[i][2] * c[i][2] + c[i][3] * c[i][3]; }
          const int rn = row + G * 8;
          if (rn < T_TOK) {
#pragma unroll
              for (int i = 0; i < 8; ++i) v[i] = __builtin_nontemporal_load((const f32x4v*)(P.x + (size_t)rn * DM + (i * 64 + lane) * 4)); }
#pragma unroll
          for (int o = 32; o; o >>= 1) s += __shfl_xor(s, o);
          const float rstd = __builtin_amdgcn_rsqf(s * (1.f / DM) + EPSN);
#pragma unroll
          for (int i = 0; i < 8; ++i) { const f32x4v g4 = *(const f32x4v*)(P.g_mix + (i * 64 + lane) * 4); const f32x4v y = c[i] * rstd * g4;
              u32x2v w; w.x = cvtpk2(y[0], y[1]); w.y = cvtpk2(y[2], y[3]); *(u32x2v*)(H + (size_t)row * DM + (i * 64 + lane) * 4) = w; } } }
}

__device__ void phase_dt(const Params& P, unsigned char* lds) {
    const int tid = opaque_tid(), w = tid >> 6, lane = tid & 63, quad = lane >> 4, l15 = lane & 15;
    const u16* H = (const u16*)((unsigned char*)P.out + DO_H); const u16* W = (const u16*)((unsigned char*)P.out + DO_WIN) + (size_t)13312 * DM;
    float* D = (float*)(P.ws + WS_DT); float* red = (float*)lds;
    for (int rb = blockIdx.x; rb < T_TOK / 64; rb += gridDim.x) {
        f32x4v acc[4][4];
#pragma unroll
        for (int i = 0; i < 4; ++i)
#pragma unroll
            for (int j = 0; j < 4; ++j) acc[i][j] = (f32x4v){0.f, 0.f, 0.f, 0.f};
        const u16* Hb = H + (size_t)(rb * 64 + l15) * DM + w * 256 + quad * 8; const u16* Wb = W + (size_t)l15 * DM + w * 256 + quad * 8;
#pragma unroll 1
        for (int half = 0; half < 2; ++half) {
            bf16x8v a[4][4], b[4][4];
#pragma unroll
            for (int ks = 0; ks < 4; ++ks)
#pragma unroll
                for (int i = 0; i < 4; ++i) { a[ks][i] = *(const bf16x8v*)(Hb + (size_t)(i * 16) * DM + (half * 4 + ks) * 32); b[ks][i] = *(const bf16x8v*)(Wb + (size_t)(i * 16) * DM + (half * 4 + ks) * 32); }
#pragma unroll
            for (int ks = 0; ks < 4; ++ks)
#pragma unroll
                for (int i = 0; i < 4; ++i)
#pragma unroll
                    for (int j = 0; j < 4; ++j) acc[i][j] = MFMA16(a[ks][i], b[ks][j], acc[i][j]);
        }
        __syncthreads();
#pragma unroll
        for (int i = 0; i < 4; ++i)
#pragma unroll
            for (int j = 0; j < 4; ++j)
#pragma unroll
                for (int e2 = 0; e2 < 4; ++e2) red[(w * 64 + i * 16 + quad * 4 + e2) * 64 + j * 16 + l15] = acc[i][j][e2];
        __syncthreads();
        for (int o = tid; o < 4096; o += 512) { float s2 = 0.f;
#pragma unroll
            for (int ww = 0; ww < 8; ++ww) s2 += red[ww * 4096 + o];
            D[(size_t)(rb * 64 + (o >> 6)) * 64 + (o & 63)] = s2; }
    }
    __syncthreads();
}
__device__ void phase_conv(const Params& P) {
    const int tid = opaque_tid(), ch0 = tid * 8;
    float wgt[5][8], bia[8];
#pragma unroll
    for (int j = 0; j < 5; ++j) { const f32x4v a = *(const f32x4v*)(P.conv_w + j * 4096 + ch0), b = *(const f32x4v*)(P.conv_w + j * 4096 + ch0 + 4);
#pragma unroll
        for (int e = 0; e < 4; ++e) { wgt[j][e] = a[e]; wgt[j][4 + e] = b[e]; } }
    { const f32x4v a = *(const f32x4v*)(P.conv_b + ch0), b = *(const f32x4v*)(P.conv_b + ch0 + 4);
#pragma unroll
      for (int e = 0; e < 4; ++e) { bia[e] = a[e]; bia[4 + e] = b[e]; } }
    const u16* RAW = (const u16*)(P.ws + WS_R0); u16* OUTP = (u16*)((unsigned char*)P.out + DO_XBC);
#define CONV_LOAD(it_, dst) do { const int t0_ = (it_) * 16, s0_ = t0_ & (SEQ - 1); _Pragma("unroll") for (int r = 0; r < 20; ++r) { const bool ok = (r >= 2 || s0_ != 0) && (r < 18 || s0_ + 16 != SEQ); \
        dst[r] = (u32x4v){0u, 0u, 0u, 0u}; if (ok) dst[r] = *(const u32x4v*)(RAW + (size_t)(t0_ + r - 2) * 4096 + ch0); } } while (0)
    u32x4v nrows[20];
    if ((int)blockIdx.x < 1024) CONV_LOAD(blockIdx.x, nrows);
    for (int it = blockIdx.x; it < 1024; it += gridDim.x) {
        const int t0 = it * 16;
        u32x4v rows[20];
#pragma unroll
        for (int r = 0; r < 20; ++r) rows[r] = nrows[r];
        { const int nit = it + gridDim.x; if (nit < 1024) CONV_LOAD(nit, nrows); }
        float win[5][8];
#pragma unroll
        for (int r = 0; r < 4; ++r) unpack_bf8(rows[r], win[r]);
#pragma unroll
        for (int tt = 0; tt < 16; ++tt) {
            unpack_bf8(rows[tt + 4], win[4]);
            float o[8];
#pragma unroll
            for (int e = 0; e < 8; ++e) { float a = bia[e];
#pragma unroll
                for (int j = 0; j < 5; ++j) a = fmaf(wgt[j][e], win[j][e], a);
                o[e] = siluf_(a); }
            *(bf16x8v*)(OUTP + (size_t)(t0 + tt) * 4096 + ch0) = pack_bf8(o);
#pragma unroll
            for (int j = 0; j < 4; ++j)
#pragma unroll
                for (int e = 0; e < 8; ++e) win[j][e] = win[j + 1][e];
        }
    }
}
#undef CONV_LOAD
__device__ void phase_knorm_rope(const Params& P) {
    const int tid = opaque_tid(), l16 = tid & 15; const float* tab = (const float*)(P.ws + WS_ROPE);
    u16* K = (u16*)(P.ws + WS_K);
    const int NR = T_TOK * 4; const float* g = P.k_norm_g;
    int r = blockIdx.x * 32 + (tid >> 4); const int rstep = gridDim.x * 32; u32x4v curq = {0u, 0u, 0u, 0u};
    if (r < NR) curq = *(const u32x4v*)(K + (size_t)(r >> 2) * 512 + (r & 3) * 128 + l16 * 8);
    for (; r < NR; r += rstep) {
        const int token = r >> 2; u16* ptr = K + (size_t)token * 512 + (r & 3) * 128;
        float v[8]; unpack_bf8(curq, v);
        { const int rn = r + rstep; if (rn < NR) curq = *(const u32x4v*)(K + (size_t)(rn >> 2) * 512 + (rn & 3) * 128 + l16 * 8); }
        float s = 0.f;
#pragma unroll
        for (int e = 0; e < 8; ++e) s += v[e] * v[e];
        s += __shfl_xor(s, 1); s += __shfl_xor(s, 2); s += __shfl_xor(s, 4); s += __shfl_xor(s, 8);
        const float rstd = __builtin_amdgcn_rsqf(s * (1.f / 128.f) + EPSN);
        const f32x4v g0 = *(const f32x4v*)(g + l16 * 8), g1 = *(const f32x4v*)(g + l16 * 8 + 4);
#pragma unroll
        for (int e = 0; e < 4; ++e) { v[e] *= rstd * g0[e]; v[4 + e] *= rstd * g1[e]; }
        const int sp = token & (SEQ - 1); const int pos = (l16 < 8) ? (sp >> 6) : (sp & 63); const int j0 = (l16 & 7) * 4;
        const f32x4v c0 = *(const f32x4v*)(tab + (pos * 32 + j0) * 2), c1 = *(const f32x4v*)(tab + (pos * 32 + j0) * 2 + 4);
        float o[8];
        o[0] = v[0] * c0[0] - v[1] * c0[1]; o[1] = v[0] * c0[1] + v[1] * c0[0];
        o[2] = v[2] * c0[2] - v[3] * c0[3]; o[3] = v[2] * c0[3] + v[3] * c0[2];
        o[4] = v[4] * c1[0] - v[5] * c1[1]; o[5] = v[4] * c1[1] + v[5] * c1[0];
        o[6] = v[6] * c1[2] - v[7] * c1[3]; o[7] = v[6] * c1[3] + v[7] * c1[2];
        *(bf16x8v*)(ptr + l16 * 8) = pack_bf8(o);
    }
}

constexpr int PX = 528, PB = 272;
__device__ __forceinline__ void ssd_dt_load(const Params& P, int t0, int g, float& r0v, float& r1v) {
    const int tid = opaque_tid(), w = tid >> 6, lane = tid & 63, hh = w & 3, dir = w >> 2, h = g * 4 + hh;
    const float* DT = (const float*)(P.ws + WS_DT);
    const int r0 = 2 * lane, l0 = dir ? 127 - r0 : r0, l1 = dir ? 126 - r0 : r0 + 1;
    r0v = DT[(size_t)(t0 + l0) * 64 + dir * 32 + h]; r1v = DT[(size_t)(t0 + l1) * 64 + dir * 32 + h];
}
__device__ __forceinline__ float ssd_tables(const Params& P, int g, float r0v, float r1v, float* acum, float* dtab) {
    const int tid = opaque_tid(), w = tid >> 6, lane = tid & 63, hh = w & 3, dir = w >> 2, h = g * 4 + hh;
    const float bias = dir ? P.dt_bias_b[h] : P.dt_bias_f[h];
    const float A = -__expf(dir ? P.a_log_b[h] : P.a_log_f[h]);
    const int r0 = 2 * lane, l0 = dir ? 127 - r0 : r0, l1 = dir ? 126 - r0 : r0 + 1;
    const float x0 = r0v + bias, x1 = r1v + bias;
    const float d0 = x0 > 20.f ? x0 : log1pf(__expf(x0)), d1 = x1 > 20.f ? x1 : log1pf(__expf(x1));
    const float a0 = A * d0, a1 = A * d1, s1 = a0 + a1; float v = s1;
#pragma unroll
    for (int d = 1; d < 64; d <<= 1) { const float t = __shfl_up(v, d); if (lane >= d) v += t; }
    const float ex = v - s1;
    acum[w * 128 + l0] = ex + a0; acum[w * 128 + l1] = ex + s1; dtab[w * 128 + l0] = d0; dtab[w * 128 + l1] = d1;
    return __shfl(v, 63);
}
__device__ __forceinline__ void ssd_stage_xb(const u16* XBC, int t0, int g, unsigned char* Ximg, unsigned char* Bimg) {
    const int tid = opaque_tid();
#pragma unroll
    for (int i = 0; i < 8; ++i) { const int q = tid + 512 * i, row = q >> 5, ch = q & 31; *(u32x4v*)(Ximg + row * PX + ch * 16) = *(const u32x4v*)(XBC + (size_t)(t0 + row) * 4096 + g * 256 + ch * 8); }
#pragma unroll
    for (int i = 0; i < 4; ++i) { const int q = tid + 512 * i, row = q >> 4, ch = q & 15; *(u32x4v*)(Bimg + row * PB + ch * 16) = *(const u32x4v*)(XBC + (size_t)(t0 + row) * 4096 + 2048 + g * 128 + ch * 8); }
}
__device__ __forceinline__ void ssd_xb_load(const u16* XBC, int t0, int g, u32x4v (&xr)[8], u32x4v (&br)[4]) {
    const int tid = opaque_tid();
#pragma unroll
    for (int i = 0; i < 8; ++i) { const int q = tid + 512 * i, row = q >> 5, ch = q & 31; xr[i] = *(const u32x4v*)(XBC + (size_t)(t0 + row) * 4096 + g * 256 + ch * 8); }
#pragma unroll
    for (int i = 0; i < 4; ++i) { const int q = tid + 512 * i, row = q >> 4, ch = q & 15; br[i] = *(const u32x4v*)(XBC + (size_t)(t0 + row) * 4096 + 2048 + g * 128 + ch * 8); }
}
__device__ __forceinline__ void ssd_xb_store(const u32x4v (&xr)[8], const u32x4v (&br)[4], unsigned char* Ximg, unsigned char* Bimg) {
    const int tid = opaque_tid();
#pragma unroll
    for (int i = 0; i < 8; ++i) { const int q = tid + 512 * i, row = q >> 5, ch = q & 31; *(u32x4v*)(Ximg + row * PX + ch * 16) = xr[i]; }
#pragma unroll
    for (int i = 0; i < 4; ++i) { const int q = tid + 512 * i, row = q >> 4, ch = q & 15; *(u32x4v*)(Bimg + row * PB + ch * 16) = br[i]; }
}
__device__ void ssd_chunk_states_all(const Params& P, unsigned char* lds) {
    const u16* XBC0 = (const u16*)((unsigned char*)P.out + DO_XBC);
    u32x4v xr[8], br[4]; float dr0 = 0.f, dr1 = 0.f;
    int item = blockIdx.x;
    if (item < 1024) { const int b0 = item >> 8, c0 = (item >> 3) & 31, g0 = item & 7, tt = b0 * SEQ + c0 * 128; ssd_dt_load(P, tt, g0, dr0, dr1); ssd_xb_load(XBC0, tt, g0, xr, br); }
    for (; item < 1024; item += gridDim.x) {
    const int tid = opaque_tid(), w = tid >> 6, lane = tid & 63, hh = w & 3, dir = w >> 2, quad = lane >> 4, l15 = lane & 15;
    const int b = item >> 8, c = (item >> 3) & 31, g = item & 7, t0 = b * SEQ + c * 128, h = g * 4 + hh;
    unsigned char* Ximg = lds; unsigned char* Bimg = lds + 128 * PX;
    float* acum = (float*)(lds + 128 * PX + 128 * PB); float* dtab = acum + 1024; float* wtab = dtab + 1024; float* tot = wtab + 1024;
    __syncthreads();
    ssd_xb_store(xr, br, Ximg, Bimg);
    const float total = ssd_tables(P, g, dr0, dr1, acum, dtab);
    if (lane == 0) { tot[w] = total; ((float*)(P.ws + WS_CDEC))[((b * 32 + c) * 32 + h) * 2 + dir] = __expf(total); }
    __syncthreads();
    for (int i = tid; i < 1024; i += 512) wtab[i] = dtab[i] * __expf(tot[i >> 7] - acum[i]);
    { const int nitem = item + gridDim.x;
      if (nitem < 1024) { const int nb = nitem >> 8, nc = (nitem >> 3) & 31, ng = nitem & 7, nt0 = nb * SEQ + nc * 128; ssd_dt_load(P, nt0, ng, dr0, dr1); ssd_xb_load(XBC0, nt0, ng, xr, br); } }
    __syncthreads();
    f32x4v acc[8][4];
#pragma unroll
    for (int nb = 0; nb < 8; ++nb)
#pragma unroll
        for (int pb = 0; pb < 4; ++pb) acc[nb][pb] = (f32x4v){0.f, 0.f, 0.f, 0.f};
    const int trow = quad * 8 + (l15 >> 2), tcol = (l15 & 3) * 4;
#pragma unroll 1
    for (int ks = 0; ks < 4; ++ks) {
        const f32x4v w0 = *(const f32x4v*)(wtab + w * 128 + ks * 32 + quad * 8), w1 = *(const f32x4v*)(wtab + w * 128 + ks * 32 + quad * 8 + 4);
        bf16x8v bfr[4];
#pragma unroll
        for (int pb = 0; pb < 4; ++pb) {
            const unsigned char* px = Ximg + (ks * 32 + trow) * PX + (hh * 64 + pb * 16 + tcol) * 2;
            const s16x4v lo = tr_read16(px), hi = tr_read16(px + 4 * PX);
            float m[8];
#pragma unroll
            for (int j = 0; j < 4; ++j) { m[j] = bf2f((u16)lo[j]) * w0[j]; m[4 + j] = bf2f((u16)hi[j]) * w1[j]; }
            bfr[pb] = pack_bf8(m); }
#pragma unroll
        for (int nb = 0; nb < 8; ++nb) {
            const unsigned char* pbm = Bimg + (ks * 32 + trow) * PB + (nb * 16 + tcol) * 2;
            const s16x4v lo = tr_read16(pbm), hi = tr_read16(pbm + 4 * PB);
            const bf16x8v afr = {lo[0], lo[1], lo[2], lo[3], hi[0], hi[1], hi[2], hi[3]};
#pragma unroll
            for (int pb = 0; pb < 4; ++pb) acc[nb][pb] = MFMA16(afr, bfr[pb], acc[nb][pb]); }
    }
    u16* ST = (u16*)(P.ws + WS_R0) + ((((size_t)(b * 32 + c) * 32 + h) * 2 + dir) * 64) * 128;
#pragma unroll
    for (int nb = 0; nb < 8; ++nb)
#pragma unroll
        for (int pb = 0; pb < 4; ++pb) { u32x2v o; o.x = cvtpk2(acc[nb][pb][0], acc[nb][pb][1]); o.y = cvtpk2(acc[nb][pb][2], acc[nb][pb][3]);
            *(u32x2v*)(ST + (pb * 16 + l15) * 128 + nb * 16 + quad * 4) = o; }
    }
}
template <bool DUMP = false> __device__ void phase_scan(const Params& P) {
    u16* ST = (u16*)(P.ws + WS_R0); u16* DMP = (u16*)(P.ws + WS_DUMP); const float* CD = (const float*)(P.ws + WS_CDEC);
    for (int v = blockIdx.x * 512 + opaque_tid(); v < 262144; v += gridDim.x * 512) {
        const int n8 = v & 15, p = (v >> 4) & 63, dir = (v >> 10) & 1, h = (v >> 11) & 31, b = v >> 16;
        float st[8];
#pragma unroll
        for (int e = 0; e < 8; ++e) st[e] = 0.f;
#pragma unroll 1
        for (int i0 = 0; i0 < 32; i0 += 8) {
            u32x4v raw[8]; float dec[8]; size_t idx[8];
#pragma unroll
            for (int k = 0; k < 8; ++k) { const int i = i0 + k, c = dir ? 31 - i : i;
                idx[k] = ((((size_t)(b * 32 + c) * 32 + h) * 2 + dir) * 64 + p) * 128 + n8 * 8;
                raw[k] = *(const u32x4v*)(ST + idx[k]); dec[k] = CD[((b * 32 + c) * 32 + h) * 2 + dir]; }
#pragma unroll
            for (int k = 0; k < 8; ++k) { float f[8]; unpack_bf8(raw[k], f);
                if (DUMP) *(bf16x8v*)(DMP + (idx[k] & 0xfffff)) = pack_bf8(st); else *(bf16x8v*)(ST + idx[k]) = pack_bf8(st);
#pragma unroll
                for (int e = 0; e < 8; ++e) st[e] = fmaf(st[e], dec[k], f[e]); }
        }
    }
}
template <bool DUMP = false> __device__ void ssd_output(const Params& P, unsigned char* lds, int item) {
    const int tid = opaque_tid(), w = tid >> 6, lane = tid & 63, quad = lane >> 4, l15 = lane & 15;
    const int b = item >> 8, c = (item >> 3) & 31, g = item & 7, t0 = b * SEQ + c * 128;
    const u16* XBC = (const u16*)((unsigned char*)P.out + DO_XBC);
    unsigned char* Ximg = lds; unsigned char* Bimg = lds + 128 * PX; unsigned char* Simg = Bimg + 128 * PB;
    float* acum = (float*)(Simg + 128 * PB); float* dtab = acum + 1024;
    const u16* STb = (const u16*)(P.ws + WS_R0);
    const u16* Z = (const u16*)(P.ws + WS_Z); u16* ZO = DUMP ? (u16*)(P.ws + WS_DUMP) - (size_t)t0 * 2048 : (u16*)(P.ws + WS_Z);
    const int l = 16 * w + l15;
    bf16x8v cfr[4];
#pragma unroll
    for (int ks = 0; ks < 4; ++ks) cfr[ks] = *(const bf16x8v*)(XBC + (size_t)(t0 + l) * 4096 + 3072 + g * 128 + ks * 32 + quad * 8);
    __syncthreads();
    float dr0, dr1; ssd_dt_load(P, t0, g, dr0, dr1);
    ssd_stage_xb(XBC, t0, g, Ximg, Bimg);
    (void)ssd_tables(P, g, dr0, dr1, acum, dtab);
    __syncthreads();
    const u16* STb0 = STb; (void)STb0;
    u32x4v sreg[8];
#define SSD_SLOAD(hp_) do { _Pragma("unroll") for (int i = 0; i < 8; ++i) { const int q = tid + 512 * i, hl = q >> 11, d = (q >> 10) & 1, row = (q >> 4) & 63, ch = q & 15; \
        sreg[i] = *(const u32x4v*)(STb + ((((size_t)(b * 32 + c) * 32 + g * 4 + (hp_) * 2 + hl) * 2 + d) * 64 + row) * 128 + ch * 8); } } while (0)
#define SSD_SWRITE() do { _Pragma("unroll") for (int i = 0; i < 8; ++i) { const int q = tid + 512 * i, img = q >> 10, row = (q >> 4) & 63, ch = q & 15; \
        *(u32x4v*)(S2 + (img * 64 + row) * PB + ch * 16) = sreg[i]; } } while (0)
    SSD_SLOAD(0);
    f32x4v gt[8];
#pragma unroll
    for (int sb = 0; sb < 8; ++sb) { gt[sb] = (f32x4v){0.f, 0.f, 0.f, 0.f};
#pragma unroll
        for (int ks = 0; ks < 4; ++ks) { const bf16x8v a = *(const bf16x8v*)(Bimg + (sb * 16 + l15) * PB + (ks * 32 + quad * 8) * 2); gt[sb] = MFMA16(a, cfr[ks], gt[sb]); } }
    float ssq = 0.f;
    const int wh = w >> 1;
    unsigned char* S2 = Bimg;
#pragma unroll 1
    for (int hp = 0; hp < 2; ++hp) {
        __syncthreads();
        SSD_SWRITE();
        __syncthreads();
        if (hp == 0) SSD_SLOAD(1);
#pragma unroll 1
    for (int hl = 0; hl < 2; ++hl) {
        const int hh = hp * 2 + hl, h = g * 4 + hh;
        const size_t zoff = (size_t)(t0 + l) * 2048 + g * 256 + hh * 64 + quad * 16;
        const u32x4v zq0 = *(const u32x4v*)(Z + zoff), zq1 = *(const u32x4v*)(Z + zoff + 8);
        f32x4v y[4];
#pragma unroll
        for (int pb = 0; pb < 4; ++pb) y[pb] = (f32x4v){0.f, 0.f, 0.f, 0.f};
#pragma unroll
        for (int dir = 0; dir < 2; ++dir) {
            const float* ac = acum + (dir * 4 + hh) * 128; const float* dtb = dtab + (dir * 4 + hh) * 128;
            const float acl = ac[l];
#pragma unroll 1
            for (int kk = 0; kk < 4; ++kk) {
                const bool active = dir == 0 ? (kk <= wh) : (kk >= wh);
                if (!active) continue;
                float m[8];
#pragma unroll
                for (int half = 0; half < 2; ++half) { const int s0 = kk * 32 + half * 16 + quad * 4;
                    const f32x4v as = *(const f32x4v*)(ac + s0), ds = *(const f32x4v*)(dtb + s0);
                    const f32x4v gv = half == 0 ? (kk == 0 ? gt[0] : kk == 1 ? gt[2] : kk == 2 ? gt[4] : gt[6]) : (kk == 0 ? gt[1] : kk == 1 ? gt[3] : kk == 2 ? gt[5] : gt[7]);
#pragma unroll
                    for (int j = 0; j < 4; ++j) { const int s = s0 + j; const bool ok = dir == 0 ? (s <= l) : (s >= l);
                        const float e = __expf(fminf(acl - as[j], 0.f));
                        m[half * 4 + j] = ok ? gv[j] * e * ds[j] : 0.f; } }
                const bf16x8v afr = pack_bf8(m);
#pragma unroll
                for (int pb = 0; pb < 4; ++pb) {
                    const unsigned char* px = Ximg + (kk * 32 + quad * 4 + (l15 >> 2)) * PX + (hh * 64 + (l15 & 3) * 16 + pb * 4) * 2;
                    const s16x4v lo = tr_read16(px), hi = tr_read16(px + 16 * PX);
                    const bf16x8v xfr = {lo[0], lo[1], lo[2], lo[3], hi[0], hi[1], hi[2], hi[3]};
                    y[pb] = MFMA16(xfr, afr, y[pb]); }
            }
            const float el = __expf(acl);
#pragma unroll
            for (int ks = 0; ks < 4; ++ks) { float cf[8]; unpack_bf8(*reinterpret_cast<const u32x4v*>(&cfr[ks]), cf);
#pragma unroll
                for (int e = 0; e < 8; ++e) cf[e] *= el;
                const bf16x8v a = pack_bf8(cf);
#pragma unroll
                for (int pb = 0; pb < 4; ++pb) { const bf16x8v sf = *(const bf16x8v*)(S2 + ((hl * 2 + dir) * 64 + (l15 >> 2) * 16 + pb * 4 + (l15 & 3)) * PB + (ks * 32 + quad * 8) * 2); y[pb] = MFMA16(sf, a, y[pb]); } }
        }
        const float Dh = P.d_skip[h];
        { float xv[16], zv[16], o[16];
          unpack_bf8(*(const u32x4v*)(Ximg + l * PX + (hh * 64 + quad * 16) * 2), xv); unpack_bf8(*(const u32x4v*)(Ximg + l * PX + (hh * 64 + quad * 16 + 8) * 2), xv + 8);
          unpack_bf8(zq0, zv); unpack_bf8(zq1, zv + 8);
#pragma unroll
          for (int pb = 0; pb < 4; ++pb)
#pragma unroll
              for (int j = 0; j < 4; ++j) { const int c = pb * 4 + j; const float yv = (y[pb][j] + Dh * xv[c]) * siluf_(zv[c]); ssq += yv * yv; o[c] = yv; }
          *(bf16x8v*)(ZO + zoff) = pack_bf8(o); *(bf16x8v*)(ZO + zoff + 8) = pack_bf8(o + 8); }
    }
    }
#undef SSD_SLOAD
#undef SSD_SWRITE
    ssq += __shfl_xor(ssq, 16); ssq += __shfl_xor(ssq, 32);
    const float rstd = __builtin_amdgcn_rsqf(ssq * (1.f / 256.f) + EPSN);
    { u32x4v zq[4][2];
#pragma unroll
      for (int hh = 0; hh < 4; ++hh) { const size_t zoff = (size_t)(t0 + l) * 2048 + g * 256 + hh * 64 + quad * 16; zq[hh][0] = *(const u32x4v*)(ZO + zoff); zq[hh][1] = *(const u32x4v*)(ZO + zoff + 8); }
#pragma unroll
      for (int hh = 0; hh < 4; ++hh) { const size_t zoff = (size_t)(t0 + l) * 2048 + g * 256 + hh * 64 + quad * 16; const float* ngp = P.ssm_norm_g + g * 256 + hh * 64 + quad * 16;
        float v[16], o[16]; unpack_bf8(zq[hh][0], v); unpack_bf8(zq[hh][1], v + 8);
#pragma unroll
        for (int q4 = 0; q4 < 4; ++q4) { const f32x4v ng = *(const f32x4v*)(ngp + q4 * 4);
#pragma unroll
            for (int j = 0; j < 4; ++j) o[q4 * 4 + j] = v[q4 * 4 + j] * rstd * ng[j]; }
        *(bf16x8v*)(ZO + zoff) = pack_bf8(o); *(bf16x8v*)(ZO + zoff + 8) = pack_bf8(o + 8); } }
}
#ifndef DUPMASK
#define DUPMASK 0
#endif
__global__ void __launch_bounds__(512, 2) fwd_megakernel(Params P) {
    extern __shared__ __attribute__((aligned(16))) unsigned char lds[];
    cg::grid_group grid = cg::this_grid();
    const int G = gridDim.x, bid = blockIdx.x, tid = opaque_tid();
    unsigned char* ws = P.ws; unsigned char* dob = (unsigned char*)P.out;
    PG8_LAS unsigned char* glds = (PG8_LAS unsigned char*)lds;

    unsigned* barw = (unsigned*)(ws + WS_BAR);
    volatile LAS unsigned* bst = (volatile LAS unsigned*)(glds + LDS_BYTES - 16); if (tid < 4) bst[tid] = 0u;
    __syncthreads();
    const XcdBarrier xbar = xcd_barrier_post(barw, bst);
    if (P.seq < 0) grid.sync();
    if (DUPMASK & (4 | 32)) { phase_prep(P, lds); __syncthreads(); }
    phase_prep(P, lds);
    xcd_barrier(xbar);
    phase_dt(P, lds);
    const int late = (bid >> 3) & 1, hrank = ((bid >> 4) << 3) | (bid & 7);
    const int hrem = (G & 15) - 8 * late, hcount = (G >> 4) * 8 + (hrem < 0 ? 0 : (hrem > 8 ? 8 : hrem));
    if (late) wt_loop<1>(P, (u16*)lds, 0, 1024, hrank, hcount);
    { pg8::Gemm g{(const u16*)(dob + DO_H), (const u16*)(dob + DO_WIN), T_TOK, NPROJ_PAD, DM}; pg8::StaticOrder S; S.init(T_TOK, NPROJ_PAD, G, bid);
      pg8::EpiProj E{ws}; if (DUPMASK & 1) pg8::gemm_phase<pg8::EpiProj, pg8::StaticOrder, true, true>(glds, g, S, E);
      pg8::gemm_phase<pg8::EpiProj, pg8::StaticOrder, true, true>(glds, g, S, E); }
    if (!late) wt_loop<1>(P, (u16*)lds, 1024, 2048, hrank, hcount);
    xcd_barrier(xbar);
    if (DUPMASK & (4 | 64)) phase_conv(P);
    phase_conv(P);
    phase_knorm_rope(P);
    xcd_barrier(xbar);
    for (int it = bid; it < 1024; it += G) {
        const int round = it >> 8, blk = it & 255, xcd = blk & 7, slot = blk >> 3, kvh = xcd & 3, sub = (xcd >> 2) * 32 + slot, hq = kvh * 4 + (sub >> 4), qb = sub & 15;
        const size_t tokq = (size_t)round * SEQ + qb * 256;
        const long q0 = (long)tokq * 2048 + hq * 128, k0 = (long)round * SEQ * 512 + kvh * 128;
        att::bf16* Qb = P.aq + q0; const att::bf16* Kh = P.ak + k0; const att::bf16* Vh = P.av + k0;
        __syncthreads();
        if (DUPMASK & 2) { att::attn_dense_body<att::bf16>(Qb, Kh, Vh, (att::bf16*)(ws + WS_DUMP) + (blk & 7) * 128, P.seq, (char*)lds, P.q_norm_g, (const float*)(ws + WS_ROPE), qb * 256); __syncthreads(); }
        att::attn_dense_body<att::bf16>(Qb, Kh, Vh, Qb, P.seq, (char*)lds, P.q_norm_g, (const float*)(ws + WS_ROPE), qb * 256);
    }
    __syncthreads();
    ssd_chunk_states_all(P, lds);
    xcd_barrier(xbar);
    if (DUPMASK & (8 | 128)) phase_scan<true>(P);
    phase_scan<false>(P);
    xcd_barrier(xbar);
    if (DUPMASK & 8) for (int it = bid; it < 1024; it += G) ssd_output<true>(P, lds, it);
    for (int it = bid; it < 1024; it += G) ssd_output<false>(P, lds, it);
    xcd_barrier(xbar);
    { pg8::StaticOrder S; S.init(T_TOK, DM, G, bid);
      pg8::Gemm g{(const u16*)(ws + WS_Z), (const u16*)(ws + WS_WSSM), T_TOK, DM, DM, (const u16*)(ws + WS_Q), (const u16*)(ws + WS_WATT)};
      pg8::EpiGate2 E{ws + WS_GA, ws + WS_GB, (u16*)(ws + WS_MG)};
      pg8::gemm_phase<pg8::EpiGate2, pg8::StaticOrder, true, true, true>(glds, g, S, E); }
    xcd_barrier(xbar);
    { pg8::Gemm g{(const u16*)(ws + WS_MG), (const u16*)(ws + WS_WOUT), T_TOK, DM, DM}; pg8::StaticOrder S; S.init(T_TOK, DM, G, bid);
      pg8::EpiResB<0> E{P.x, (u16*)(ws + WS_R0), (float*)(ws + WS_SSQ1)}; pg8::gemm_phase<pg8::EpiResB<0>, pg8::StaticOrder, true, true>(glds, g, S, E); }
    xcd_barrier(xbar);
    if (late) wt_loop<2>(P, (u16*)lds, 0, 1024, hrank, hcount);
    { pg8::Gemm g{(const u16*)(ws + WS_R0), (const u16*)(ws + WS_W1T), T_TOK, DFF, DM}; pg8::StaticOrder S; S.init(T_TOK, DFF, G, bid);
      pg8::EpiMlpIn E{(u16*)(ws + WS_U), (const float*)(ws + WS_SSQ1)}; if (DUPMASK & (1 | 256)) pg8::gemm_phase<pg8::EpiMlpIn, pg8::StaticOrder, true, true>(glds, g, S, E); pg8::gemm_phase<pg8::EpiMlpIn, pg8::StaticOrder, true, true>(glds, g, S, E); }
    if (!late) wt_loop<2>(P, (u16*)lds, 1024, 2048, hrank, hcount);
    xcd_barrier(xbar);
    { pg8::Gemm g{(const u16*)(ws + WS_U), (const u16*)(ws + WS_W2T), T_TOK, DM, DFF}; pg8::StaticOrder S; S.init(T_TOK, DM, G, bid);
      pg8::EpiResB<1> E{nullptr, (u16*)(ws + WS_R0), (float*)(ws + WS_SSQ2)}; pg8::gemm_phase<pg8::EpiResB<1>, pg8::StaticOrder, true, true>(glds, g, S, E); }
    xcd_barrier(xbar);
    { const int lane = tid & 63; const float* SS = (const float*)(ws + WS_SSQ2); const u16* X2 = (const u16*)(ws + WS_R0);
      int row = bid * 8 + (tid >> 6); u32x4v nq[4]; float ns = 0.f;
      if (row < T_TOK) { ns = SS[(size_t)row * 32 + (lane & 31)];
#pragma unroll
          for (int i = 0; i < 4; ++i) nq[i] = *(const u32x4v*)(X2 + (size_t)row * DM + (i * 64 + lane) * 8); }
      for (; row < T_TOK; row += G * 8) {
          u32x4v xq[4]; float s = ns;
#pragma unroll
          for (int i = 0; i < 4; ++i) xq[i] = nq[i];
          { const int rn = row + G * 8; if (rn < T_TOK) { ns = SS[(size_t)rn * 32 + (lane & 31)];
#pragma unroll
              for (int i = 0; i < 4; ++i) nq[i] = *(const u32x4v*)(X2 + (size_t)rn * DM + (i * 64 + lane) * 8); } }
#pragma unroll
          for (int o = 16; o; o >>= 1) s += __shfl_xor(s, o);
          const float rstd = __builtin_amdgcn_rsqf(s * (1.f / DM) + EPSN);
          float* xr = P.out + (size_t)row * DM;
#pragma unroll
          for (int i = 0; i < 4; ++i) { const int cidx = (i * 64 + lane) * 8; float v[8]; unpack_bf8(xq[i], v);
              const f32x4v g0 = *(const f32x4v*)(P.g_final + cidx), g1 = *(const f32x4v*)(P.g_final + cidx + 4);
              f32x4v o0, o1;
#pragma unroll
              for (int j = 0; j < 4; ++j) { o0[j] = v[j] * rstd * g0[j]; o1[j] = v[4 + j] * rstd * g1[j]; }
              *(f32x4v*)(xr + cidx) = o0; *(f32x4v*)(xr + cidx + 4) = o1; } } }
}

extern "C" void kernel_launch(void* const* d_in, const int* in_sizes, int n_in, void* d_out, int out_size, void* d_ws, size_t ws_size, hipStream_t stream) {
    static int grid_blocks = 0;
    if (grid_blocks == 0) {
        if (n_in != 20 || in_sizes[0] != T_TOK * DM || out_size != T_TOK * DM || ws_size < WS_END) {
            fprintf(stderr, "kernel_launch: shape mismatch n_in %d in0 %d out %d ws %zu (need %zu)\n", n_in, n_in > 0 ? in_sizes[0] : -1, out_size, ws_size, (size_t)WS_END); grid_blocks = -1; return; }
        int dev = 0, cus = 0, per_cu = 0;
        (void)hipGetDevice(&dev); (void)hipDeviceGetAttribute(&cus, hipDeviceAttributeMultiprocessorCount, dev);
        if (hipFuncSetAttribute((const void*)fwd_megakernel, hipFuncAttributeMaxDynamicSharedMemorySize, LDS_BYTES) != hipSuccess) { fprintf(stderr, "kernel_launch: hipFuncSetAttribute failed\n"); grid_blocks = -1; return; }
        if (hipOccupancyMaxActiveBlocksPerMultiprocessor(&per_cu, (const void*)fwd_megakernel, 512, LDS_BYTES) != hipSuccess || per_cu < 1) { fprintf(stderr, "kernel_launch: occupancy query says %d\n", per_cu); per_cu = 1; }
        (void)hipGetLastError();
        grid_blocks = cus * 1;
    }
    if (grid_blocks < 0) return;
    Params p{};
    p.x = (const float*)d_in[0]; p.g_mix = (const float*)d_in[1]; p.w_in = (const float*)d_in[2]; p.conv_w = (const float*)d_in[3]; p.conv_b = (const float*)d_in[4];
    p.dt_bias_f = (const float*)d_in[5]; p.dt_bias_b = (const float*)d_in[6]; p.a_log_f = (const float*)d_in[7]; p.a_log_b = (const float*)d_in[8]; p.d_skip = (const float*)d_in[9];
    p.ssm_norm_g = (const float*)d_in[10]; p.q_norm_g = (const float*)d_in[11]; p.k_norm_g = (const float*)d_in[12]; p.w_ssm_up = (const float*)d_in[13]; p.w_attn_up = (const float*)d_in[14];
    p.w_out = (const float*)d_in[15]; p.g_mlp = (const float*)d_in[16]; p.w_mlp_in = (const float*)d_in[17]; p.w_mlp_out = (const float*)d_in[18]; p.g_final = (const float*)d_in[19];
    p.out = (float*)d_out; p.ws = (unsigned char*)d_ws; p.seq = SEQ; p.pad = 0; p.aq = (__hip_bfloat16*)((unsigned char*)d_ws + WS_Q); p.ak = (const __hip_bfloat16*)((unsigned char*)d_ws + WS_K); p.av = (const __hip_bfloat16*)((unsigned char*)d_ws + WS_V);
    if (hipMemsetAsync((unsigned char*)d_ws + WS_BAR, 0, XCD_BAR_WORDS * sizeof(unsigned), stream) != hipSuccess) { fprintf(stderr, "kernel_launch: memset of the barrier words failed\n"); return; }
    void* args[] = {&p};
    hipError_t e = hipLaunchCooperativeKernel((const void*)fwd_megakernel, dim3(grid_blocks), dim3(512), args, LDS_BYTES, stream);
    if (e != hipSuccess) fprintf(stderr, "kernel_launch: cooperative launch failed: %s (grid %d)\n", hipGetErrorString(e), grid_blocks);
}
```
